# Optimizing an MI355X kernel written in HIP

```python
import math
import jax, jax.numpy as jnp
from jax import lax
import numpy as np

D_MODEL = 1024
BATCH = 8
SEQ = 8192
DEPTH = 4

GRID_W = 64
CTX_LEN = 256
HEAD_DIM = 64
Q_BLOCK = 128
ROPE_THETA = 10000.0
EPS = 1e-6
N_MOD = 6

A_HEADS = D_MODEL // 256
A_VDIM = 2 * HEAD_DIM
B_HEADS = D_MODEL // 128
B_KV_HEADS = B_HEADS // 4
B_GROUP = B_HEADS // B_KV_HEADS
A_Q = A_HEADS * 2 * HEAD_DIM
A_K = A_HEADS * 2 * HEAD_DIM
A_V = A_HEADS * A_VDIM
B_Q = B_HEADS * HEAD_DIM
B_K = B_KV_HEADS * HEAD_DIM
B_V = B_KV_HEADS * HEAD_DIM
EVEN_SPLITS = [A_Q, A_Q + A_K, A_Q + A_K + A_V, A_Q + A_K + A_V + B_Q, A_Q + A_K + A_V + B_Q + B_K]
EVEN_IN = A_Q + A_K + A_V + B_Q + B_K + B_V
A_OUT = A_HEADS * A_VDIM
B_OUT = B_HEADS * HEAD_DIM

MLA_HEADS = D_MODEL // 64
MLA_NOPE = 64
MLA_ROPE = 32
MLA_VDIM = 64
MLA_Q_RANK = D_MODEL // 4
MLA_KV_RANK = D_MODEL // 8
ODD_IN = MLA_Q_RANK + MLA_KV_RANK + MLA_ROPE
MLA_OUT = MLA_HEADS * MLA_VDIM

N_EXPERTS = 16
EC_CAPACITY_FACTOR = 2
D_EXPERT = D_MODEL

N_EVEN = (DEPTH + 1) // 2
N_ODD = DEPTH // 2

kernel_name = 'hybrid_diffattn_gqa_mla_ec_moe_prefix_trunk'


def rmsnorm(x, g):
    xf = x.astype(jnp.float32)
    y = xf * lax.rsqrt(jnp.mean(xf * xf, axis=-1, keepdims=True) + EPS)
    return y.astype(x.dtype) * g


def modulate(h, shift, scale):
    return h * (1 + scale) + shift


def grid_angles(n_tokens, rot_dim):
    rows = n_tokens // GRID_W
    row = jnp.repeat(jnp.arange(rows, dtype=jnp.float32), GRID_W)
    col = jnp.tile(jnp.arange(GRID_W, dtype=jnp.float32), rows)
    half = rot_dim // 2
    freqs = ROPE_THETA ** (-jnp.arange(0, half, 2, dtype=jnp.float32) / half)
    return row[:, None] * freqs, col[:, None] * freqs


def rope_1d(x, ang):
    ang = ang.reshape((ang.shape[0],) + (1,) * (x.ndim - 3) + (ang.shape[1],))
    cos = jnp.cos(ang).astype(x.dtype)
    sin = jnp.sin(ang).astype(x.dtype)
    x1, x2 = jnp.split(x, 2, axis=-1)
    return jnp.concatenate([x1 * cos - x2 * sin, x2 * cos + x1 * sin], axis=-1)


def rope_2d(x, ang_row, ang_col):
    xr, xc = jnp.split(x, 2, axis=-1)
    return jnp.concatenate([rope_1d(xr, ang_row), rope_1d(xc, ang_col)], axis=-1)


def sweep_query_blocks(fn, *qs):
    bsz, t = qs[0].shape[:2]
    nb = t // Q_BLOCK
    blocks = tuple(jnp.moveaxis(q.reshape((bsz, nb, Q_BLOCK) + q.shape[2:]), 1, 0) for q in qs)
    out = lax.map(lambda qb: fn(*qb), blocks)
    return jnp.moveaxis(out, 0, 1).reshape((bsz, t) + out.shape[3:])


def diff_attend(q, k, v, lam, scale):
    s = jnp.einsum('bqhcd,bkhcd->bhcqk', q, k).astype(jnp.float32) * scale
    p = jax.nn.softmax(s, axis=-1)
    w = (p[:, :, 0] - lam * p[:, :, 1]).astype(v.dtype)
    return jnp.einsum('bhqk,bkhd->bqhd', w, v)


def gqa_attend(q, k, v, scale):
    s = jnp.einsum('bqhgd,bkhd->bhgqk', q, k).astype(jnp.float32) * scale
    p = jax.nn.softmax(s, axis=-1).astype(v.dtype)
    return jnp.einsum('bhgqk,bkhd->bqhgd', p, v)


def mla_attend(qn, qr, kn, kr, v, scale):
    s = jnp.einsum('bqhd,bkhd->bhqk', qn, kn) + jnp.einsum('bqhr,bkr->bhqk', qr, kr)
    p = jax.nn.softmax(s.astype(jnp.float32) * scale, axis=-1).astype(v.dtype)
    return jnp.einsum('bhqk,bkhd->bqhd', p, v)


def even_project(h, w_in, a_qk, b_qk):
    bsz, t = h.shape[:2]
    qa, ka, va, qb, kb, vb = jnp.split(h @ w_in, EVEN_SPLITS, axis=-1)
    qa = rmsnorm(qa.reshape(bsz, t, A_HEADS, 2, HEAD_DIM), a_qk[0])
    ka = rmsnorm(ka.reshape(bsz, t, A_HEADS, 2, HEAD_DIM), a_qk[1])
    va = va.reshape(bsz, t, A_HEADS, A_VDIM)
    qb = rmsnorm(qb.reshape(bsz, t, B_KV_HEADS, B_GROUP, HEAD_DIM), b_qk[0])
    kb = rmsnorm(kb.reshape(bsz, t, B_KV_HEADS, HEAD_DIM), b_qk[1])
    vb = vb.reshape(bsz, t, B_KV_HEADS, HEAD_DIM)
    return qa, ka, va, qb, kb, vb


def even_mixer(h_lat, h_ctx, w_in, a_qk, lam_vecs, a_subln, b_qk, w_out, layer_idx, ctx_out):
    lam_init = 0.8 - 0.6 * math.exp(-0.3 * layer_idx)
    lv = lam_vecs.astype(jnp.float32)
    lam = jnp.exp(jnp.sum(lv[0] * lv[1])) - jnp.exp(jnp.sum(lv[2] * lv[3])) + lam_init
    scale = HEAD_DIM ** -0.5
    qa_l, ka_l, va_l, qb_l, kb_l, vb_l = even_project(h_lat, w_in, a_qk, b_qk)
    qa_c, ka_c, va_c, qb_c, kb_c, vb_c = even_project(h_ctx, w_in, a_qk, b_qk)
    ang_row, ang_col = grid_angles(h_lat.shape[1], HEAD_DIM)
    qa_l, ka_l, qb_l, kb_l = (rope_2d(t, ang_row, ang_col) for t in (qa_l, ka_l, qb_l, kb_l))
    ka = jnp.concatenate([ka_l, ka_c], axis=1)
    va = jnp.concatenate([va_l, va_c], axis=1)
    kb = jnp.concatenate([kb_l, kb_c], axis=1)
    vb = jnp.concatenate([vb_l, vb_c], axis=1)
    oa_l = sweep_query_blocks(lambda q: diff_attend(q, ka, va, lam, scale), qa_l)
    ob_l = sweep_query_blocks(lambda q: gqa_attend(q, kb, vb, scale), qb_l)

    def merge(oa, ob):
        bsz, t = oa.shape[:2]
        oa = rmsnorm(oa, a_subln) * (1.0 - lam_init)
        return jnp.concatenate([oa.reshape(bsz, t, A_OUT), ob.reshape(bsz, t, B_OUT)], axis=-1) @ w_out

    y_lat = merge(oa_l, ob_l)
    y_ctx = None
    if ctx_out:
        y_ctx = merge(diff_attend(qa_c, ka_c, va_c, lam, scale), gqa_attend(qb_c, kb_c, vb_c, scale))
    return y_lat, y_ctx


def mla_project(h, w_in, q_norm, w_q_up, kv_norm, w_kv_up, qk_norm):
    bsz, t = h.shape[:2]
    cq, ckv, kr = jnp.split(h @ w_in, [MLA_Q_RANK, MLA_Q_RANK + MLA_KV_RANK], axis=-1)
    q = (rmsnorm(cq, q_norm) @ w_q_up).reshape(bsz, t, MLA_HEADS, MLA_NOPE + MLA_ROPE)
    kv = (rmsnorm(ckv, kv_norm) @ w_kv_up).reshape(bsz, t, MLA_HEADS, MLA_NOPE + MLA_VDIM)
    qn = rmsnorm(q[..., :MLA_NOPE], qk_norm[0, :MLA_NOPE])
    qr = rmsnorm(q[..., MLA_NOPE:], qk_norm[0, MLA_NOPE:])
    kn = rmsnorm(kv[..., :MLA_NOPE], qk_norm[1, :MLA_NOPE])
    v = kv[..., MLA_NOPE:]
    kr = rmsnorm(kr, qk_norm[1, MLA_NOPE:])
    return qn, qr, kn, kr, v


def odd_mixer(h_lat, h_ctx, w_in, q_norm, w_q_up, kv_norm, w_kv_up, qk_norm, w_out, ctx_out):
    scale = (MLA_NOPE + MLA_ROPE) ** -0.5
    qn_l, qr_l, kn_l, kr_l, v_l = mla_project(h_lat, w_in, q_norm, w_q_up, kv_norm, w_kv_up, qk_norm)
    qn_c, qr_c, kn_c, kr_c, v_c = mla_project(h_ctx, w_in, q_norm, w_q_up, kv_norm, w_kv_up, qk_norm)
    ang_row, ang_col = grid_angles(h_lat.shape[1], MLA_ROPE)
    qr_l = rope_2d(qr_l, ang_row, ang_col)
    kr_l = rope_2d(kr_l, ang_row, ang_col)
    kn = jnp.concatenate([kn_l, kn_c], axis=1)
    kr = jnp.concatenate([kr_l, kr_c], axis=1)
    v = jnp.concatenate([v_l, v_c], axis=1)
    o_l = sweep_query_blocks(lambda a, b: mla_attend(a, b, kn, kr, v, scale), qn_l, qr_l)
    bsz, t = h_lat.shape[:2]
    y_lat = o_l.reshape(bsz, t, MLA_OUT) @ w_out
    y_ctx = None
    if ctx_out:
        o_c = mla_attend(qn_c, qr_c, kn_c, kr_c, v_c, scale)
        y_ctx = o_c.reshape(bsz, h_ctx.shape[1], MLA_OUT) @ w_out
    return y_lat, y_ctx


def ec_moe(h, w_router, w_gate, w_up, w_down):
    bsz, t, d = h.shape
    cap = EC_CAPACITY_FACTOR * t // N_EXPERTS
    aff = jax.nn.softmax(jnp.einsum('btd,de->bte', h, w_router).astype(jnp.float32), axis=-1)
    gates, idx = lax.top_k(jnp.swapaxes(aff, 1, 2), cap)
    xs = jax.vmap(lambda hb, ib: hb[ib])(h, idx)
    a = jnp.einsum('becd,edf->becf', xs, w_gate)
    u = jnp.einsum('becd,edf->becf', xs, w_up)
    y = jnp.einsum('becf,efd->becd', jax.nn.silu(a) * u, w_down)
    y = y * gates[..., None].astype(y.dtype)
    return jax.vmap(lambda yb, ib: jnp.zeros((t, d), y.dtype).at[ib.reshape(-1)].add(yb.reshape(-1, d)))(y, idx)


def setup_inputs(seed: int = 0) -> dict:
    key = jax.random.key(seed)
    ks = iter(jax.random.split(key, 32))

    def nrm(shape, scale):
        return jax.random.normal(next(ks), shape, jnp.float32) * scale

    def gain(shape):
        return 1.0 + nrm(shape, 0.1)

    D = D_MODEL
    return {
        'x': nrm((BATCH, SEQ, D), 1.0),
        'c': nrm((BATCH, D), 1.0),
        'ctx': nrm((BATCH, CTX_LEN, D), 1.0),
        'c_ctx': nrm((D,), 1.0),
        'w_ada': nrm((DEPTH, D, N_MOD * D), 0.5 * D ** -0.5),
        'b_ada': nrm((DEPTH, N_MOD * D), 0.01),
        'norm_mix': gain((DEPTH, D)),
        'norm_ffn': gain((DEPTH, D)),
        'w_in_even': nrm((N_EVEN, D, EVEN_IN), D ** -0.5),
        'a_qk_norm': gain((N_EVEN, 2, HEAD_DIM)),
        'diff_lambda': nrm((N_EVEN, 4, HEAD_DIM), 0.1),
        'a_subln': gain((N_EVEN, A_VDIM)),
        'b_qk_norm': gain((N_EVEN, 2, HEAD_DIM)),
        'w_out_even': nrm((N_EVEN, A_OUT + B_OUT, D), (A_OUT + B_OUT) ** -0.5),
        'w_in_odd': nrm((N_ODD, D, ODD_IN), D ** -0.5),
        'mla_q_norm': gain((N_ODD, MLA_Q_RANK)),
        'w_q_up': nrm((N_ODD, MLA_Q_RANK, MLA_HEADS * (MLA_NOPE + MLA_ROPE)), MLA_Q_RANK ** -0.5),
        'mla_kv_norm': gain((N_ODD, MLA_KV_RANK)),
        'w_kv_up': nrm((N_ODD, MLA_KV_RANK, MLA_HEADS * (MLA_NOPE + MLA_VDIM)), MLA_KV_RANK ** -0.5),
        'mla_qk_norm': gain((N_ODD, 2, MLA_NOPE + MLA_ROPE)),
        'w_out_odd': nrm((N_ODD, MLA_OUT, D), MLA_OUT ** -0.5),
        'w_router': nrm((DEPTH, D, N_EXPERTS), D ** -0.5),
        'w_exp_gate': nrm((DEPTH, N_EXPERTS, D, D_EXPERT), D ** -0.5),
        'w_exp_up': nrm((DEPTH, N_EXPERTS, D, D_EXPERT), D ** -0.5),
        'w_exp_down': nrm((DEPTH, N_EXPERTS, D_EXPERT, D), D_EXPERT ** -0.5),
    }


def reference(x, c, ctx, c_ctx, w_ada, b_ada, norm_mix, norm_ffn, w_in_even, a_qk_norm, diff_lambda,
              a_subln, b_qk_norm, w_out_even, w_in_odd, mla_q_norm, w_q_up, mla_kv_norm, w_kv_up,
              mla_qk_norm, w_out_odd, w_router, w_exp_gate, w_exp_up, w_exp_down):
    bsz = x.shape[0]
    sc = jax.nn.silu(c)
    sc_ctx = jax.nn.silu(c_ctx)
    for i in range(DEPTH):
        last = i == DEPTH - 1
        m = (sc @ w_ada[i] + b_ada[i]).reshape(bsz, 1, N_MOD, D_MODEL)
        mc = (sc_ctx @ w_ada[i] + b_ada[i]).reshape(N_MOD, D_MODEL)
        h_lat = modulate(rmsnorm(x, norm_mix[i]), m[:, :, 0], m[:, :, 1])
        h_ctx = modulate(rmsnorm(ctx, norm_mix[i]), mc[0], mc[1])
        if i % 2 == 0:
            j = i // 2
            y_lat, y_ctx = even_mixer(h_lat, h_ctx, w_in_even[j], a_qk_norm[j], diff_lambda[j], a_subln[j],
                                      b_qk_norm[j], w_out_even[j], i, not last)
        else:
            j = i // 2
            y_lat, y_ctx = odd_mixer(h_lat, h_ctx, w_in_odd[j], mla_q_norm[j], w_q_up[j], mla_kv_norm[j],
                                     w_kv_up[j], mla_qk_norm[j], w_out_odd[j], not last)
        x = x + m[:, :, 2] * y_lat
        h_lat = modulate(rmsnorm(x, norm_ffn[i]), m[:, :, 3], m[:, :, 4])
        x = x + m[:, :, 5] * ec_moe(h_lat, w_router[i], w_exp_gate[i], w_exp_up[i], w_exp_down[i])
        if not last:
            ctx = ctx + mc[2] * y_ctx
            h_ctx = modulate(rmsnorm(ctx, norm_ffn[i]), mc[3], mc[4])
            ctx = ctx + mc[5] * ec_moe(h_ctx, w_router[i], w_exp_gate[i], w_exp_up[i], w_exp_down[i])
    return x
```

```cpp
#include <hip/hip_runtime.h>
#include <cstdio>
#include <cstdint>

#define LAS __attribute__((address_space(3)))
#define GAS __attribute__((address_space(1)))
typedef unsigned short bf16_t;
typedef short bf16x8 __attribute__((ext_vector_type(8)));
typedef float f32x4 __attribute__((ext_vector_type(4)));
typedef float f32x2 __attribute__((ext_vector_type(2)));
typedef float f32x16 __attribute__((ext_vector_type(16)));
typedef unsigned u32x4 __attribute__((ext_vector_type(4)));
typedef unsigned u32x2 __attribute__((ext_vector_type(2)));
typedef __bf16 bf16x2_t __attribute__((ext_vector_type(2)));

constexpr int DM = 1024, NB = 8, SEQ = 8192, CTXL = 256, TPS = SEQ + CTXL, NR = NB * TPS;
constexpr int NEXP = 16, CAP_L = 1024, CAP_C = 32;
constexpr int NPAIR_L = NB * NEXP * CAP_L, NPAIR = NPAIR_L + NEXP * NB * CAP_C;
constexpr int QKW = 1792, VEW = 768, QW = 1536, CNW = 512;
constexpr float EPS = 1e-6f;
constexpr float LOG2E = 1.4426950408889634f;
constexpr float C2_EVEN = 0.125f * LOG2E;
constexpr float C2_ODD = 0.10206207261596577f * LOG2E;

constexpr size_t al(size_t x) { return (x + 255) & ~(size_t)255; }
constexpr size_t WS_CTL = 0, CTL_BYTES = 1u << 20;
constexpr size_t WS_MOD = WS_CTL + CTL_BYTES;
constexpr size_t WS_ROPE64 = WS_MOD + al((size_t)4 * 9 * 6 * 1024 * 4);
constexpr size_t WS_ROPE32 = WS_ROPE64 + al(128 * 16 * 2 * 4);
constexpr size_t WS_WP = WS_ROPE32 + al(128 * 8 * 2 * 4);
constexpr size_t WS_WQK = WS_WP + al((size_t)9 * 16384 * 4 + 9 * 16 * 4);
constexpr size_t WS_WVE = WS_WQK + al((size_t)2 * QKW * 1024 * 2);
constexpr size_t WS_WOE = WS_WVE + al((size_t)2 * VEW * 1024 * 2);
constexpr size_t WS_WINO = WS_WOE + al((size_t)2 * 1024 * 1024 * 2);
constexpr size_t WS_WQUP = WS_WINO + al((size_t)2 * 512 * 1024 * 2);
constexpr size_t WS_WKN = WS_WQUP + al((size_t)2 * 1536 * 256 * 2);
constexpr size_t WS_WVO = WS_WKN + al((size_t)2 * 1024 * 256 * 2);
constexpr size_t WS_WOO = WS_WVO + al((size_t)2 * 1024 * 256 * 2);
constexpr size_t WS_WGU = WS_WOO + al((size_t)2 * 1024 * 1024 * 2);
constexpr size_t WS_WD = WS_WGU + al((size_t)16 * 2048 * 1024 * 2);
constexpr size_t WS_XCTX = WS_WD + al((size_t)16 * 1024 * 1024 * 2);
constexpr size_t WS_H = WS_XCTX + al((size_t)NB * CTXL * 1024 * 4);
constexpr size_t WS_AFF = WS_H + al((size_t)NR * 1024 * 2);
constexpr size_t WS_SLOT = WS_AFF + al((size_t)NR * 16 * 4);
constexpr size_t WS_TOK = WS_SLOT + al((size_t)NR * 16 * 4);
constexpr size_t WS_BIG = WS_TOK + al((size_t)NPAIR * 4);
constexpr size_t WS_QK = WS_BIG;
constexpr size_t WS_VTE = WS_QK + al((size_t)NR * QKW * 2);
constexpr size_t WS_OB = WS_VTE + al((size_t)VEW * NR * 2);
constexpr size_t WS_END_E = WS_OB + al((size_t)NR * 1024 * 2);
constexpr size_t WS_CRAW = WS_BIG;
constexpr size_t WS_CN = WS_CRAW + al((size_t)NR * 512 * 4);
constexpr size_t WS_KR = WS_CN + al((size_t)NR * CNW * 2);
constexpr size_t WS_Q = WS_KR + al((size_t)NR * 32 * 2);
constexpr size_t WS_KN = WS_Q + al((size_t)NR * QW * 2);
constexpr size_t WS_VTO = WS_KN + al((size_t)NR * 1024 * 2);
constexpr size_t WS_END_O = WS_VTO + al((size_t)1024 * NR * 2);
constexpr size_t WS_GACT = WS_BIG;
constexpr size_t WS_Y = WS_GACT + al((size_t)NPAIR * 1024 * 2);
constexpr size_t WS_END_M = WS_Y + al((size_t)NPAIR * 1024 * 2);
constexpr size_t WS_NEED = (WS_END_O > WS_END_E ? (WS_END_O > WS_END_M ? WS_END_O : WS_END_M) : (WS_END_E > WS_END_M ? WS_END_E : WS_END_M));

constexpr int RING_BYTES = 131072;
constexpr int LDSCTL_OFF = RING_BYTES, MISC_OFF = LDSCTL_OFF + 320;
constexpr int LDS_BYTES = 147456;
constexpr int NWAVES = 8;

__device__ __forceinline__ unsigned cvtpk(float lo, float hi) { f32x2 v = {lo, hi}; bf16x2_t b = __builtin_convertvector(v, bf16x2_t); return __builtin_bit_cast(unsigned, b); }
__device__ __forceinline__ float bf_lo(unsigned w) { return __uint_as_float(w << 16); }
__device__ __forceinline__ float bf_hi(unsigned w) { return __uint_as_float(w & 0xffff0000u); }
__device__ __forceinline__ float wave_sum(float v) {
#pragma unroll
    for (int o = 1; o < 64; o <<= 1) v += __shfl_xor(v, o);
    return v;
}
#define LDS_WAIT() asm volatile("s_waitcnt lgkmcnt(0)" ::: "memory")
#define VM_WAIT() asm volatile("s_waitcnt vmcnt(0)" ::: "memory")

namespace pg8 {
constexpr int BM = 256, BK = 64, HALF = 128, HTB = HALF * BK * 2, STAGE_BYTES = 8 * HTB, NXCD = 8, WGM = 8;
__host__ __device__ __forceinline__ int lds_byte(int r, int c) { const int st = (r >> 4) * 2 + (c >> 5), rr = r & 15, cc = c & 31, ob = rr * 64 + cc * 2; return st * 1024 + (ob ^ (((ob >> 9) & 1) << 5)); }
__host__ __device__ __forceinline__ void stage_rc(int b, int& R, int& C) { const int st = b / 1024, sb = b % 1024, swz = sb ^ (((sb >> 9) & 1) << 5); R = (st >> 1) * 16 + swz / 64; C = (st & 1) * 32 + (swz % 64) / 2; }
__host__ __device__ __forceinline__ int perm32(int rho) { const int n = rho >> 4, i = rho & 15; return 8 * (i >> 2) + 4 * n + (i & 3); }

struct Unit { int pm, pn; };
struct Gemm { const bf16_t* A; const bf16_t* Bt; int lda, ldb, K; const int* gidx; };

struct StaticOrder {
    int nM, nN, nwg, G, c, lat;
    __device__ void init(int M, int N, int G_, int c_, int lat_ = 0) { nM = M / BM; nN = N / BM; nwg = nM * nN; G = G_; c = c_; lat = lat_; }
    __device__ bool next(int i, Unit& u) const {
        const long L = (long)i * G + c; if (L >= nwg) return false;
        int wgid = (int)L; { const int q = nwg / NXCD, r = nwg % NXCD, xcd = wgid % NXCD, off = wgid / NXCD; wgid = (xcd < r ? xcd * (q + 1) : r * (q + 1) + (xcd - r) * q) + off; }
        const int nig = WGM * nN, gid = wgid / nig, fm = gid * WGM, gsz = (nM - fm) < WGM ? (nM - fm) : WGM;
        u.pm = fm + ((wgid % nig) % gsz); u.pn = (wgid % nig) / gsz; if (lat) u.pm = (u.pm >> 5) * 33 + (u.pm & 31); return true;
    }
};
template <int NJ> struct MoeOrder {
    int G, c, nrt;
    __device__ bool next(int i, Unit& u) const {
        const int L = i * G + c; if (L >= 16 * nrt * NJ) return false;
        const int e = L / (nrt * NJ), rem = L - e * (nrt * NJ), rt = rem / NJ, j = rem - rt * NJ;
        u.pm = (rt < 32) ? (((rt >> 2) * 16 + e) * 4 + (rt & 3)) : (512 + e);
        u.pn = e * NJ + j; return true;
    }
};

struct EpiBf16 {
    static constexpr bool PERM = true;
    bf16_t* O; size_t ldc; int pnmask;
    __device__ __forceinline__ void operator()(const f32x4 (&acc)[2][2][4][2], const Unit& u, int wr, int wc, int fr, int fq) const {
        const int row0 = u.pm * BM + wr * 64 + fr; const int col0 = (u.pn & pnmask) * BM + wc * 32 + 8 * fq;
#pragma unroll
        for (int ai = 0; ai < 2; ++ai)
#pragma unroll
            for (int m = 0; m < 4; ++m) { bf16_t* rowp = O + (size_t)(row0 + ai * HALF + m * 16) * ldc + col0;
#pragma unroll
                for (int bj = 0; bj < 2; ++bj) { const f32x4 v0 = acc[ai][bj][m][0], v1 = acc[ai][bj][m][1];
                    u32x4 w; w.x = cvtpk(v0[0], v0[1]); w.y = cvtpk(v0[2], v0[3]); w.z = cvtpk(v1[0], v1[1]); w.w = cvtpk(v1[2], v1[3]);
                    *(u32x4*)(rowp + bj * HALF) = w; } }
    }
};
struct EpiF32 {
    static constexpr bool PERM = false;
    float* O; size_t ldc;
    __device__ __forceinline__ void operator()(const f32x4 (&acc)[2][2][4][2], const Unit& u, int wr, int wc, int fr, int fq) const {
        const int row0 = u.pm * BM + wr * 64 + fr; const int col0 = u.pn * BM + wc * 32 + 4 * fq;
#pragma unroll
        for (int ai = 0; ai < 2; ++ai)
#pragma unroll
            for (int m = 0; m < 4; ++m) { float* rowp = O + (size_t)(row0 + ai * HALF + m * 16) * ldc + col0;
#pragma unroll
                for (int bj = 0; bj < 2; ++bj)
#pragma unroll
                    for (int n = 0; n < 2; ++n) *(f32x4*)(rowp + bj * HALF + n * 16) = acc[ai][bj][m][n]; }
    }
};
struct EpiResid {
    static constexpr bool PERM = false;
    float* xl; float* xc; const float* mod; int gk;
    __device__ __forceinline__ void operator()(const f32x4 (&acc)[2][2][4][2], const Unit& u, int wr, int wc, int fr, int fq) const {
        const int b = u.pm / 33, j = u.pm - b * 33;
        float* base = (j < 32) ? xl + ((size_t)(b * SEQ + j * 256)) * DM : xc + ((size_t)(b * CTXL)) * DM;
        const float* gv = mod + ((j < 32 ? b : 8) * 6 + gk) * 1024;
        const int rl0 = wr * 64 + fr; const int col0 = u.pn * BM + wc * 32 + 4 * fq;
        f32x4 g[2][2];
#pragma unroll
        for (int bj = 0; bj < 2; ++bj)
#pragma unroll
            for (int n = 0; n < 2; ++n) g[bj][n] = *(const f32x4*)(gv + col0 + bj * HALF + n * 16);
#pragma unroll
        for (int ai = 0; ai < 2; ++ai)
#pragma unroll
            for (int m = 0; m < 4; ++m) { float* rowp = base + (size_t)(rl0 + ai * HALF + m * 16) * DM + col0;
#pragma unroll
                for (int bj = 0; bj < 2; ++bj)
#pragma unroll
                    for (int n = 0; n < 2; ++n) { f32x4* p = (f32x4*)(rowp + bj * HALF + n * 16); const f32x4 xv = *p; *p = xv + g[bj][n] * acc[ai][bj][m][n]; }
                asm volatile("" ::: "memory"); }
    }
};
struct EpiSwiGLU {
    static constexpr bool PERM = true;
    bf16_t* O;
    __device__ __forceinline__ void operator()(const f32x4 (&acc)[2][2][4][2], const Unit& u, int wr, int wc, int fr, int fq) const {
        const int row0 = u.pm * BM + wr * 64 + fr; const int col0 = (u.pn & 7) * HALF + wc * 32 + 8 * fq;
#pragma unroll
        for (int ai = 0; ai < 2; ++ai)
#pragma unroll
            for (int m = 0; m < 4; ++m) { bf16_t* rowp = O + (size_t)(row0 + ai * HALF + m * 16) * DM + col0;
                float r[8];
#pragma unroll
                for (int n = 0; n < 2; ++n)
#pragma unroll
                    for (int k = 0; k < 4; ++k) { const float a = acc[ai][0][m][n][k], up = acc[ai][1][m][n][k];
                        r[n * 4 + k] = a * __builtin_amdgcn_rcpf(1.f + __builtin_amdgcn_exp2f(-a * LOG2E)) * up; }
                u32x4 w; w.x = cvtpk(r[0], r[1]); w.y = cvtpk(r[2], r[3]); w.z = cvtpk(r[4], r[5]); w.w = cvtpk(r[6], r[7]);
                *(u32x4*)rowp = w; }
    }
};

template <class Epi, class Sched, bool GATHER = false>
__device__ __forceinline__ void gemm_phase(LAS unsigned char* lds, const Gemm g, const Sched& S, const Epi& E) {
    int tid_ = threadIdx.x; asm volatile("" : "+v"(tid_));
    const int tid = tid_, wid = __builtin_amdgcn_readfirstlane(tid >> 6), lane = tid & 63, wr = wid >> 2, wc = wid & 3, fr = lane & 15, fq = lane >> 4;
    const int K = g.K, nt = K / BK;
    int RA[2], CA[2]; unsigned voffB[2];
#pragma unroll
    for (int i = 0; i < 2; ++i) { int R, C; stage_rc(tid * 16 + i * 8192, R, C); const int Rb = Epi::PERM ? ((R & ~31) + perm32(R & 31)) : R;
        RA[i] = R; CA[i] = C; voffB[i] = (unsigned)(Rb * g.ldb + C) * 2u; }
    const size_t kstep = (size_t)(BK * 2);
    const size_t hstepB = (size_t)HALF * g.ldb * 2, tstepB = 2 * hstepB, hstepA = (size_t)HALF * g.lda * 2, tstepA = 2 * hstepA;
    unsigned voA[2];
#pragma unroll
    for (int i = 0; i < 2; ++i) voA[i] = (unsigned)(RA[i] * g.lda + CA[i]) * 2u;
    const unsigned ldsw = (unsigned)wid * 1024u;
    const int aoff = lds_byte(wr * 64 + fr, fq * 8), boff = lds_byte(wc * 32 + fr, fq * 8);
    unsigned voC[2][2], voN[2][2];
#define PG8_SA(b, h) (((b) * 2 + (h)) * HTB)
#define PG8_SB(b, h) ((4 + (b) * 2 + (h)) * HTB)
#define PG8_STAGE_B(bufoff, gbase) do { _Pragma("unroll") for (int _i = 0; _i < 2; ++_i) \
        __builtin_amdgcn_global_load_lds((const unsigned*)((const char*)(gbase) + voffB[_i]), (LAS unsigned*)(lds + (bufoff) + ldsw + _i * 8192), 16, 0, 0); } while (0)
#define PG8_STAGE_A(bufoff, gbase, vo, h) do { _Pragma("unroll") for (int _i = 0; _i < 2; ++_i) { \
        if constexpr (GATHER) __builtin_amdgcn_global_load_lds((const unsigned*)((const char*)(gbase) + (vo)[h][_i]), (LAS unsigned*)(lds + (bufoff) + ldsw + _i * 8192), 16, 0, 0); \
        else __builtin_amdgcn_global_load_lds((const unsigned*)((const char*)(gbase) + (h) * hstepA + voA[_i]), (LAS unsigned*)(lds + (bufoff) + ldsw + _i * 8192), 16, 0, 0); } } while (0)
#define PG8_LDA(dst, b, h) do { _Pragma("unroll") for (int m = 0; m < 4; ++m) _Pragma("unroll") for (int k = 0; k < 2; ++k) dst[m][k] = *(const LAS bf16x8*)(lds + PG8_SA(b, h) + aoff + m * 2048 + k * 1024); } while (0)
#define PG8_LDB(dst, b, h) do { _Pragma("unroll") for (int n = 0; n < 2; ++n) _Pragma("unroll") for (int k = 0; k < 2; ++k) dst[n][k] = *(const LAS bf16x8*)(lds + PG8_SB(b, h) + boff + n * 2048 + k * 1024); } while (0)
#define PG8_MMA(ai, bj, At, Bt) do { __builtin_amdgcn_s_setprio(1); _Pragma("unroll") for (int m = 0; m < 4; ++m) _Pragma("unroll") for (int n = 0; n < 2; ++n) _Pragma("unroll") for (int k = 0; k < 2; ++k) \
        acc[ai][bj][m][n] = __builtin_amdgcn_mfma_f32_16x16x32_bf16(Bt[n][k], At[m][k], acc[ai][bj][m][n], 0, 0, 0); __builtin_amdgcn_s_setprio(0); } while (0)
#define PG8_WAIT_V(n) asm volatile("s_waitcnt vmcnt(" #n ")" ::: "memory")
#define PG8_WAIT_L(n) asm volatile("s_waitcnt lgkmcnt(" #n ")" ::: "memory")
#define PG8_BAR __builtin_amdgcn_s_barrier()
#define PG8_SCHED __builtin_amdgcn_sched_barrier(0)
#define PG8_VOFFS(vo, unit) do { if constexpr (GATHER) { _Pragma("unroll") for (int _h = 0; _h < 2; ++_h) _Pragma("unroll") for (int _i = 0; _i < 2; ++_i) \
        (vo)[_h][_i] = (unsigned)(g.gidx[(unit).pm * BM + _h * HALF + RA[_i]] * g.lda + CA[_i]) * 2u; } } while (0)
    Unit cur, nxt; int ui = 0;
    if (!S.next(0, cur)) return;
    f32x4 acc[2][2][4][2];
#pragma unroll
    for (int a = 0; a < 2; ++a)
#pragma unroll
        for (int b = 0; b < 2; ++b)
#pragma unroll
            for (int m = 0; m < 4; ++m)
#pragma unroll
                for (int n = 0; n < 2; ++n) acc[a][b][m][n] = (f32x4){0.f, 0.f, 0.f, 0.f};
    bf16x8 At[4][2], B0[2][2], B1[2][2];
    PG8_VOFFS(voC, cur);
    const char* cA = GATHER ? (const char*)g.A : (const char*)g.A + (size_t)cur.pm * tstepA; const char* cB = (const char*)g.Bt + (size_t)cur.pn * tstepB;
    PG8_STAGE_B(PG8_SB(0, 0), cB); PG8_STAGE_B(PG8_SB(0, 1), cB + hstepB); PG8_STAGE_A(PG8_SA(0, 0), cA, voC, 0); PG8_STAGE_A(PG8_SA(0, 1), cA, voC, 1);
    if (wr == 1) PG8_BAR;
    PG8_WAIT_V(2); PG8_BAR;
    PG8_STAGE_B(PG8_SB(1, 0), cB + kstep); PG8_STAGE_A(PG8_SA(1, 0), cA + kstep, voC, 0); PG8_STAGE_B(PG8_SB(1, 1), cB + hstepB + kstep);
    PG8_WAIT_V(6); PG8_BAR;
    for (;;) {
        const bool has_next = S.next(ui + 1, nxt);
        if constexpr (GATHER) { if (has_next) { PG8_VOFFS(voN, nxt); } else {
#pragma unroll
            for (int _h = 0; _h < 2; ++_h)
#pragma unroll
                for (int _i = 0; _i < 2; ++_i) voN[_h][_i] = voC[_h][_i]; } }
        const char* nA = GATHER ? (const char*)g.A : (has_next ? (const char*)g.A + (size_t)nxt.pm * tstepA : cA);
        const char* nB = has_next ? (const char*)g.Bt + (size_t)nxt.pn * tstepB : cB;
        for (int t = 0; t < nt; t += 2) {
            const bool last = (t == nt - 2);
            const char* a1 = cA + (size_t)(t + 1) * kstep;
            const char* a2 = last ? nA : cA + (size_t)(t + 2) * kstep; const char* b2 = last ? nB : cB + (size_t)(t + 2) * kstep;
            const char* a3 = a2 + kstep; const char* b3 = b2 + kstep;
            unsigned vo2[2][2];
            if constexpr (GATHER) {
#pragma unroll
            for (int _h = 0; _h < 2; ++_h)
#pragma unroll
                for (int _i = 0; _i < 2; ++_i) vo2[_h][_i] = last ? voN[_h][_i] : voC[_h][_i]; }
            PG8_LDB(B0, 0, 0); PG8_LDB(B1, 0, 1); PG8_SCHED; PG8_LDA(At, 0, 0); PG8_STAGE_A(PG8_SA(1, 1), a1, voC, 1);
            PG8_WAIT_V(8); PG8_WAIT_L(0); PG8_BAR; PG8_MMA(0, 0, At, B0); PG8_MMA(0, 1, At, B1); PG8_BAR; PG8_SCHED;
            PG8_LDA(At, 0, 1); PG8_STAGE_B(PG8_SB(0, 0), b2); PG8_STAGE_B(PG8_SB(0, 1), b2 + hstepB); PG8_STAGE_A(PG8_SA(0, 0), a2, vo2, 0);
            PG8_WAIT_V(8); PG8_WAIT_L(0); PG8_BAR; PG8_MMA(1, 0, At, B0); PG8_MMA(1, 1, At, B1); PG8_BAR; PG8_SCHED;
            PG8_LDB(B0, 1, 0); PG8_LDB(B1, 1, 1); PG8_SCHED; PG8_LDA(At, 1, 0); PG8_STAGE_A(PG8_SA(0, 1), a2, vo2, 1);
            PG8_WAIT_V(8); PG8_WAIT_L(0); PG8_BAR; PG8_MMA(0, 0, At, B0); PG8_MMA(0, 1, At, B1); PG8_BAR; PG8_SCHED;
            PG8_LDA(At, 1, 1); PG8_STAGE_B(PG8_SB(1, 0), b3); PG8_STAGE_B(PG8_SB(1, 1), b3 + hstepB); PG8_STAGE_A(PG8_SA(1, 0), a3, vo2, 0);
            PG8_WAIT_V(8); PG8_WAIT_L(0); PG8_BAR; PG8_MMA(1, 0, At, B0); PG8_MMA(1, 1, At, B1); PG8_BAR; PG8_SCHED;
        }
        if (wr == 0) PG8_BAR;
        E(acc, cur, wr, wc, fr, fq);
        if (!has_next) break;
#pragma unroll
        for (int a = 0; a < 2; ++a)
#pragma unroll
            for (int b = 0; b < 2; ++b)
#pragma unroll
                for (int m = 0; m < 4; ++m)
#pragma unroll
                    for (int n = 0; n < 2; ++n) acc[a][b][m][n] = (f32x4){0.f, 0.f, 0.f, 0.f};
        cur = nxt; cA = nA; cB = nB; ++ui;
        if constexpr (GATHER) {
#pragma unroll
        for (int _h = 0; _h < 2; ++_h)
#pragma unroll
            for (int _i = 0; _i < 2; ++_i) voC[_h][_i] = voN[_h][_i]; }
        if (wr == 1) PG8_BAR;
    }
    PG8_WAIT_V(0);
    PG8_BAR;
#undef PG8_SA
#undef PG8_SB
#undef PG8_STAGE_A
#undef PG8_STAGE_B
#undef PG8_LDA
#undef PG8_LDB
#undef PG8_MMA
#undef PG8_WAIT_V
#undef PG8_WAIT_L
#undef PG8_BAR
#undef PG8_SCHED
#undef PG8_VOFFS
}
}

typedef GAS unsigned gu32;
#define RLX_AGENT __ATOMIC_RELAXED, __HIP_MEMORY_SCOPE_AGENT
#define XB_TMO      128
#define XB_XCNT(j)  (256  + 64 * (j))
#define XB_XSUB(j)  (1280 + 64 * (j))
#define XB_XGEN(j)  (2304 + 64 * (j))
#define XB_TOP      3328
#define XB_TOPGEN   3392
#define XCD_BAR_WORDS 3456
#define XB_SPIN_CAP (1u << 22)
__device__ __forceinline__ unsigned xb_ld(unsigned* p)              { return __hip_atomic_load(p, __ATOMIC_RELAXED, __HIP_MEMORY_SCOPE_AGENT); }
__device__ __forceinline__ unsigned xb_add(unsigned* p, unsigned v) { return __hip_atomic_fetch_add(p, v, __ATOMIC_RELAXED, __HIP_MEMORY_SCOPE_AGENT); }
__device__ __forceinline__ unsigned xb_xcc_id() { return (unsigned)__builtin_amdgcn_s_getreg((3 << 11) | 20) & 0xFu; }
#define XB_SPIN(cond, bar) do { unsigned _sp = 0; while (cond) { __builtin_amdgcn_s_sleep(1); \
    if ((++_sp & 255u) == 0u) { if (xb_ld(&(bar)[XB_TMO])) break; if (_sp > XB_SPIN_CAP) { atomicAdd(&(bar)[XB_TMO], 1u); break; } } } } while (0)
struct XcdBarrier { unsigned* bar; unsigned x; volatile LAS unsigned* st; };
__device__ __forceinline__ XcdBarrier xcd_barrier_post(unsigned* bar, volatile LAS unsigned* st) {
    XcdBarrier b; b.bar = bar; b.x = xb_xcc_id(); b.st = st;
    if (threadIdx.x == 0) (void)xb_add(&bar[XB_XCNT(b.x)], 1u);
    return b;
}
__device__ __forceinline__ void xcd_barrier_complete(unsigned* bar, unsigned x, unsigned& nloc, unsigned& nx) {
    const unsigned G = gridDim.x * gridDim.y * gridDim.z;
    unsigned sum, cnt, mine, sp = 0u;
    for (;;) {
        sum = 0u; cnt = 0u; mine = 0u;
#pragma unroll
        for (unsigned j = 0; j < 16; ++j) { const unsigned c = xb_ld(&bar[XB_XCNT(j)]); sum += c; cnt += (c > 0u) ? 1u : 0u; mine = (j == x) ? c : mine; }
        if (sum == G) break;
        __builtin_amdgcn_s_sleep(1);
        if ((++sp & 255u) == 0u) { if (xb_ld(&bar[XB_TMO])) break; if (sp > XB_SPIN_CAP) { atomicAdd(&bar[XB_TMO], 1u); break; } }
    }
    nloc = mine > 0u ? mine : 1u; nx = cnt > 0u ? cnt : 1u;
}
__device__ __forceinline__ void xcd_barrier(const XcdBarrier& b) {
    asm volatile("s_waitcnt vmcnt(0)" ::: "memory");
    __syncthreads();
    if (threadIdx.x == 0) {
        unsigned* bar = b.bar;
        __builtin_amdgcn_s_waitcnt(0);
        unsigned nloc = b.st[0], nx = b.st[1];
        if (nloc == 0u) { xcd_barrier_complete(bar, b.x, nloc, nx); b.st[0] = nloc; b.st[1] = nx; }
        const unsigned old = xb_add(&bar[XB_XSUB(b.x)], 1u);
        const unsigned gen = old / nloc;
        if (old + 1u == (gen + 1u) * nloc) {
            __builtin_amdgcn_fence(__ATOMIC_RELEASE, "agent");
            asm volatile("s_waitcnt vmcnt(0)" ::: "memory");
            const unsigned og = xb_add(&bar[XB_TOP], 1u);
            const unsigned tg = og / nx;
            if (og + 1u == (tg + 1u) * nx) xb_add(&bar[XB_TOPGEN], 1u);
            else XB_SPIN(xb_ld(&bar[XB_TOPGEN]) == tg, bar);
            __builtin_amdgcn_fence(__ATOMIC_ACQUIRE, "agent");
            xb_add(&bar[XB_XGEN(b.x)], 1u);
            asm volatile("s_waitcnt vmcnt(0)" ::: "memory");
        } else {
            XB_SPIN(xb_ld(&bar[XB_XGEN(b.x)]) == gen, bar);
            __builtin_amdgcn_fence(__ATOMIC_ACQUIRE, "agent");
            asm volatile("s_waitcnt vmcnt(0)" ::: "memory");
        }
    }
    __syncthreads();
}

namespace att {
__device__ __forceinline__ void glds16(const void* gsrc, unsigned lds_dst) { unsigned keep;
    asm volatile("s_mov_b32 %0, m0\n\ts_mov_b32 m0, %2\n\ts_nop 0\n\tglobal_load_lds_dwordx4 %1, off\n\ts_mov_b32 m0, %0" : "=&s"(keep) : "v"(gsrc), "s"(lds_dst) : "memory"); }
template <int N> __device__ __forceinline__ void wait_bar() {
    static_assert(N >= 0 && N <= 3, "wait_bar");
    if constexpr (N == 0) asm volatile("s_waitcnt vmcnt(0) lgkmcnt(0)\n\ts_barrier" ::: "memory");
    else if constexpr (N == 1) asm volatile("s_waitcnt vmcnt(1) lgkmcnt(0)\n\ts_barrier" ::: "memory");
    else if constexpr (N == 2) asm volatile("s_waitcnt vmcnt(2) lgkmcnt(0)\n\ts_barrier" ::: "memory");
    else asm volatile("s_waitcnt vmcnt(3) lgkmcnt(0)\n\ts_barrier" ::: "memory");
}
__device__ __forceinline__ float lanes4_sum(float v) {
    { auto rr = __builtin_amdgcn_permlane16_swap(__float_as_uint(v), __float_as_uint(v), false, false); v = __uint_as_float(rr[0]) + __uint_as_float(rr[1]); }
    { auto rr = __builtin_amdgcn_permlane32_swap(__float_as_uint(v), __float_as_uint(v), false, false); v = __uint_as_float(rr[0]) + __uint_as_float(rr[1]); }
    return v; }
constexpr int NSLOT = 3, KOFF = 0, VOFF = NSLOT * 12288, ATT_LDS = VOFF + NSLOT * 16384;
static_assert(ATT_LDS + 8 * 4096 <= RING_BYTES, "attention LDS (rings + per-wave O stage)");
#define ATT_SB() __builtin_amdgcn_sched_barrier(0)
template <int DQK, int DV, bool LEAD>
__device__ __forceinline__ void attn_unit_impl(const bf16_t* Q, int qpitch, const bf16_t* K, int kpitch, const bf16_t* KR, const bf16_t* Vt, bf16_t* O, int opitch,
                                          int qrow0, int krow0, int NT, LAS unsigned char* shm, const float* qgain, const f32x2* rope, int tq0) {
    static_assert((DQK == 64 || DQK == 96) && (DV == 64 || DV == 128), "shapes");
    constexpr int KSLOT = DQK * 128, VSLOT = DV * 128, NKD = (DQK == 96 ? 2 : 1), NVD = DV / 64, NDMA = NKD + NVD, NDS = DQK / 32, NDB = DV / 16;
    constexpr bool KS = (DV == 64); constexpr int NQB = KS ? 4 : 2, NKW = KS ? 2 : 4, NSW = KS ? 1 : 2, NVF = KS ? 4 : 8;
    static_assert(NDMA == 2 || NDMA == 3, "dma count");
    int tid_ = threadIdx.x; asm volatile("" : "+v"(tid_));
    const int tid = tid_, lane = tid & 63, q16 = lane & 15, g4 = lane >> 4, hi = lane >> 5; const int wid = __builtin_amdgcn_readfirstlane(tid >> 6);
    const int kg = KS ? (wid >> 2) : 0, qoff = KS ? (wid & 3) * 64 : wid * 32;
    const unsigned lds0 = (unsigned)(uintptr_t)shm;
    const int krow_l = wid * 8 + (lane >> 3);
    const int kc_l = (lane & 7) ^ (((krow_l >> 1) & 1) | (((krow_l >> 3) & 1) << 1) | (((krow_l >> 4) & 1) << 2));
    const int vc_l = (lane & 7) ^ ((krow_l >> 1) & 7);
    const bf16_t* ksrc = K + (size_t)(krow0 + krow_l) * kpitch + kc_l * 8;
    const int rrow_l = (wid & 3) * 16 + (lane >> 2), rc_l = (lane & 3) ^ (((rrow_l >> 4) & 1) << 1);
    const bf16_t* krsrc = (DQK == 96) ? KR + (size_t)(krow0 + rrow_l) * 32 + rc_l * 8 : nullptr;
    const bf16_t* vsrc = Vt + (size_t)krow_l * NR + krow0 + vc_l * 8;
    const unsigned kdst = lds0 + KOFF + wid * 1024, krdst = lds0 + KOFF + 8192 + (wid & 3) * 1024, vdst = lds0 + VOFF + wid * 1024;
#define ATT_DMA_K(t, sl) do { glds16(ksrc + (size_t)(t) * 64 * kpitch, (unsigned)__builtin_amdgcn_readfirstlane(kdst + (sl) * KSLOT)); \
        if constexpr (DQK == 96) glds16(krsrc + (size_t)(t) * 64 * 32, (unsigned)__builtin_amdgcn_readfirstlane(krdst + (sl) * KSLOT)); } while (0)
#define ATT_DMA_V(t, sl) do { glds16(vsrc + (size_t)(t) * 64, (unsigned)__builtin_amdgcn_readfirstlane(vdst + (sl) * VSLOT)); \
        if constexpr (DV == 128) glds16(vsrc + (size_t)64 * NR + (size_t)(t) * 64, (unsigned)__builtin_amdgcn_readfirstlane(vdst + (sl) * VSLOT + 8192)); } while (0)
    const int kr0 = 8 * (q16 >> 2) + (q16 & 3);
    const int fk = ((kr0 >> 1) & 1) | (((kr0 >> 3) & 1) << 1) | (((kr0 >> 4) & 1) << 2);
    const LAS unsigned char* kp[2]; const LAS unsigned char* vp[2];
#pragma unroll
    for (int ds = 0; ds < 2; ++ds) kp[ds] = shm + KOFF + kr0 * 128 + ((((ds << 2) | g4) ^ fk) << 4) + kg * 4096;
    const LAS unsigned char* krp = shm + KOFF + 8192 + kr0 * 64 + ((g4 ^ (((kr0 >> 4) & 1) << 1)) << 4) + kg * 2048;
#pragma unroll
    for (int s_ = 0; s_ < 2; ++s_) vp[s_] = shm + VOFF + q16 * 128 + ((((s_ << 2) | g4) ^ ((q16 >> 1) & 7)) << 4);
    const LAS unsigned char* vpk = kg ? vp[1] : vp[0];
#define ATT_KLOAD(sl) do { _Pragma("unroll") for (int kb_ = 0; kb_ < NKW; ++kb_) _Pragma("unroll") for (int ds_ = 0; ds_ < NDS; ++ds_) { \
        if (ds_ < 2) kf[kb_ * NDS + ds_] = *(const LAS bf16x8*)(kp[ds_ & 1] + (sl) * KSLOT + (kb_ & 1) * 512 + (kb_ >> 1) * 4096); \
        else kf[kb_ * NDS + ds_] = *(const LAS bf16x8*)(krp + (sl) * KSLOT + (kb_ & 1) * 256 + (kb_ >> 1) * 2048); } } while (0)
#define ATT_QK() do { _Pragma("unroll") for (int kb_ = 0; kb_ < NKW; ++kb_) _Pragma("unroll") for (int ds_ = 0; ds_ < NDS; ++ds_) _Pragma("unroll") for (int qb_ = 0; qb_ < NQB; ++qb_) \
        c[kb_][qb_] = __builtin_amdgcn_mfma_f32_16x16x32_bf16(kf[kb_ * NDS + ds_], qf[qb_ * NDS + ds_], ds_ == 0 ? zero4 : c[kb_][qb_], 0, 0, 0); } while (0)
#define ATT_VLOAD(sl, h_) do { _Pragma("unroll") for (int g_ = 0; g_ < NVF; ++g_) { \
        if constexpr (KS) vf[g_] = *(const LAS bf16x8*)(vpk + (sl) * VSLOT + g_ * 2048); \
        else vf[g_] = *(const LAS bf16x8*)(vp[g_ & 1] + (sl) * VSLOT + ((h_) * 4 + (g_ >> 1)) * 2048); } } while (0)
#define ATT_PVP(h_) do { _Pragma("unroll") for (int g_ = 0; g_ < NVF; ++g_) _Pragma("unroll") for (int qb_ = 0; qb_ < NQB; ++qb_) { \
        const int db_ = KS ? g_ : (h_) * 4 + (g_ >> 1), sq_ = KS ? 0 : (g_ & 1); \
        o[db_][qb_] = __builtin_amdgcn_mfma_f32_16x16x32_bf16(vf[g_], __builtin_bit_cast(bf16x8, pw[sq_ * NQB + qb_]), o[db_][qb_], 0, 0, 0); } } while (0)
#define ATT_EXP() do { _Pragma("unroll") for (int kb_ = 0; kb_ < NKW; ++kb_) _Pragma("unroll") for (int qb_ = 0; qb_ < NQB; ++qb_) _Pragma("unroll") for (int i_ = 0; i_ < 4; ++i_) \
        c[kb_][qb_][i_] = __builtin_amdgcn_exp2f(c[kb_][qb_][i_]); } while (0)
#define ATT_SUMPACK() do { float pa_[NQB]; _Pragma("unroll") for (int qb_ = 0; qb_ < NQB; ++qb_) pa_[qb_] = (c[0][qb_][0] + c[0][qb_][1]) + (c[0][qb_][2] + c[0][qb_][3]); \
        _Pragma("unroll") for (int kb_ = 1; kb_ < NKW; ++kb_) _Pragma("unroll") for (int i_ = 0; i_ < 4; ++i_) { _Pragma("unroll") for (int qb_ = 0; qb_ < NQB; ++qb_) pa_[qb_] += c[kb_][qb_][i_]; \
            if constexpr (NQB == 2) asm volatile("" : "+v"(pa_[0]), "+v"(pa_[1])); else asm volatile("" : "+v"(pa_[0]), "+v"(pa_[1]), "+v"(pa_[2]), "+v"(pa_[3])); } \
        _Pragma("unroll") for (int qb_ = 0; qb_ < NQB; ++qb_) lsum[qb_] += pa_[qb_];     \
        _Pragma("unroll") for (int s_ = 0; s_ < NSW; ++s_) _Pragma("unroll") for (int qb_ = 0; qb_ < NQB; ++qb_) { \
            pw[s_ * NQB + qb_][0] = cvtpk(c[2 * s_][qb_][0], c[2 * s_][qb_][1]); pw[s_ * NQB + qb_][1] = cvtpk(c[2 * s_][qb_][2], c[2 * s_][qb_][3]); \
            pw[s_ * NQB + qb_][2] = cvtpk(c[2 * s_ + 1][qb_][0], c[2 * s_ + 1][qb_][1]); pw[s_ * NQB + qb_][3] = cvtpk(c[2 * s_ + 1][qb_][2], c[2 * s_ + 1][qb_][3]); } } while (0)
    ATT_DMA_K(0, 0); ATT_DMA_V(0, 0); ATT_DMA_K(1, 1); ATT_DMA_K(2, 2);
    bf16x8 qf[NQB * NDS];
    {
      const float c2 = (DQK == 64) ? C2_EVEN : C2_ODD; const bool lat = tq0 >= 0;
#pragma unroll
      for (int qb = 0; qb < NQB; ++qb) {
          const bf16_t* qp = Q + (size_t)(qrow0 + qoff + qb * 16 + q16) * qpitch + g4 * 8;
          bf16x8 raw[NDS];
#pragma unroll
          for (int ds = 0; ds < NDS; ++ds) raw[ds] = *(const bf16x8*)(qp + ds * 32);
          float x[NDS][8];
#pragma unroll
          for (int ds = 0; ds < NDS; ++ds)
#pragma unroll
              for (int j = 0; j < 8; ++j) x[ds][j] = __uint_as_float(((unsigned)(unsigned short)raw[ds][j]) << 16);
          const int tq = tq0 + qoff + qb * 16 + q16, prow = (tq >> 6) & 127, pcol = tq & 63;
          float sn = 0.f;
#pragma unroll
          for (int ds = 0; ds < 2; ++ds)
#pragma unroll
              for (int j = 0; j < 8; ++j) sn += x[ds][j] * x[ds][j];
          sn = lanes4_sum(sn);
          const float rn = rsqrtf(sn * (1.f / 64.f) + EPS);
#pragma unroll
          for (int ds = 0; ds < 2; ++ds)
#pragma unroll
              for (int j = 0; j < 8; ++j) x[ds][j] *= rn * qgain[32 * ds + 8 * g4 + j];
          if constexpr (DQK == 64) {
#pragma unroll
              for (int ds = 0; ds < 2; ++ds)
#pragma unroll
                  for (int j = 0; j < 8; ++j) {
                      auto rr = __builtin_amdgcn_permlane32_swap(__float_as_uint(x[ds][j]), __float_as_uint(x[ds][j]), false, false);
                      const float other = hi ? __uint_as_float(rr[0]) : __uint_as_float(rr[1]);
                      float cc = 1.f, sg = 0.f;
                      if (lat) { const f32x2 cs = rope[(ds ? pcol : prow) * 16 + 8 * (g4 & 1) + j]; cc = cs.x; sg = hi ? cs.y : -cs.y; }
                      x[ds][j] = x[ds][j] * cc + other * sg; }
          } else {
              float sr = 0.f;
#pragma unroll
              for (int j = 0; j < 8; ++j) sr += x[2][j] * x[2][j];
              sr = lanes4_sum(sr);
              const float rq = rsqrtf(sr * (1.f / 32.f) + EPS);
#pragma unroll
              for (int j = 0; j < 8; ++j) { const float av = x[2][j] * rq * qgain[64 + 8 * g4 + j];
                  auto rr = __builtin_amdgcn_permlane16_swap(__float_as_uint(av), __float_as_uint(av), false, false);
                  const float other = (g4 & 1) ? __uint_as_float(rr[0]) : __uint_as_float(rr[1]);
                  float cc = 1.f, sg = 0.f;
                  if (lat) { const f32x2 cs = rope[((g4 & 2) ? pcol : prow) * 8 + j]; cc = cs.x; sg = (g4 & 1) ? cs.y : -cs.y; }
                  x[2][j] = av * cc + other * sg; }
          }
#pragma unroll
          for (int ds = 0; ds < NDS; ++ds) { u32x4 w;
#pragma unroll
              for (int i = 0; i < 4; ++i) w[i] = cvtpk(x[ds][2 * i] * c2, x[ds][2 * i + 1] * c2);
              qf[qb * NDS + ds] = __builtin_bit_cast(bf16x8, w); }
      }
#pragma unroll
      for (int d0 = 0; d0 < NQB * NDS; ++d0) asm volatile("" : "+v"(qf[d0])); }
    wait_bar<0>();
    bf16x8 kf[NKW * NDS], vf[NVF];
    ATT_KLOAD(0);
    asm volatile("s_waitcnt lgkmcnt(0)\n\ts_barrier" ::: "memory");
    float lsum[NQB];
#pragma unroll
    for (int qb = 0; qb < NQB; ++qb) lsum[qb] = 0.f;
    const f32x4 zero4 = {0.f, 0.f, 0.f, 0.f};
    f32x4 o[NDB][NQB], c[NKW][NQB]; u32x4 pw[4];
#pragma unroll
    for (int i = 0; i < NDB; ++i)
#pragma unroll
        for (int qb = 0; qb < NQB; ++qb) o[i][qb] = zero4;
    ATT_DMA_K(3, 0); ATT_DMA_V(1, 1);
    ATT_QK(); ATT_SB();
    ATT_KLOAD(1); ATT_SB();
    if constexpr (LEAD) { ATT_EXP(); ATT_SUMPACK(); }
    wait_bar<NDMA>();
    int s_prev = 0, s_cur = 1, s_next = 2;
    int one_ = 1; asm volatile("" : "+s"(one_));
    for (int t = 1; t < NT; ++t) {
        __builtin_amdgcn_s_waitcnt(0xC07F);
        if constexpr (!LEAD) { ATT_EXP(); ATT_SUMPACK(); ATT_SB(); }
        ATT_VLOAD(s_prev, 0); ATT_SB();
        { const int tk = (t + 3 < NT) ? t + 3 : NT - 1; ATT_DMA_K(tk, s_cur); }
        { const int tv = (t + 1 < NT) ? t + 1 : NT - 1; ATT_DMA_V(tv, s_next); }
        ATT_SB();
        if constexpr (LEAD) {
            ATT_QK(); ATT_SB();
            ATT_PVP(0); ATT_SB();
            if constexpr (DV == 128) { ATT_VLOAD(s_prev, 1); ATT_SB(); ATT_EXP(); ATT_SB(); ATT_PVP(1); ATT_SB(); }
            if (one_) ATT_KLOAD(s_next);
            ATT_SB();
            if constexpr (DV == 64) ATT_EXP();
            ATT_SUMPACK();
            asm volatile("" : "+v"(pw[0]), "+v"(pw[1]), "+v"(pw[2]), "+v"(pw[3]));
#pragma unroll
            for (int qb = 0; qb < NQB; ++qb) asm volatile("" : "+v"(lsum[qb]));
        } else {
            if constexpr (DV == 128) {
                __builtin_amdgcn_s_setprio(1);
                ATT_PVP(0); ATT_SB();
                ATT_VLOAD(s_prev, 1); ATT_SB();
                ATT_QK(); ATT_SB();
                if (one_) { ATT_KLOAD(s_next); ATT_SB(); ATT_PVP(1); }
                ATT_SB();
                __builtin_amdgcn_s_setprio(0);
            } else {
                __builtin_amdgcn_s_setprio(1);
                ATT_QK(); ATT_SB();
                if (one_) { ATT_KLOAD(s_next); ATT_SB(); ATT_PVP(0); }
                ATT_SB();
                __builtin_amdgcn_s_setprio(0);
            }
#pragma unroll
            for (int kb = 0; kb < NKW; ++kb)
#pragma unroll
                for (int qb = 0; qb < NQB; ++qb) asm volatile("" : "+v"(c[kb][qb]));
        }
        ATT_SB();
        wait_bar<NDMA>();
        const int tmp = s_prev; s_prev = s_cur; s_cur = s_next; s_next = tmp;
    }
    if constexpr (!LEAD) { ATT_EXP(); ATT_SUMPACK(); ATT_SB(); }
    ATT_VLOAD(s_prev, 0); ATT_PVP(0);
    if constexpr (DV == 128) { ATT_SB(); ATT_VLOAD(s_prev, 1); ATT_PVP(1); }
#pragma unroll
    for (int qb = 0; qb < NQB; ++qb) lsum[qb] = lanes4_sum(lsum[qb]);
    if constexpr (KS) {
        wait_bar<0>();
        LAS unsigned char* xch = shm + (wid & 3) * 17408;
        if constexpr (!LEAD) {
#pragma unroll
            for (int db = 0; db < 4; ++db)
#pragma unroll
                for (int qb = 0; qb < 4; ++qb) *(LAS f32x4*)(xch + ((db * 4 + qb) * 64 + lane) * 16) = o[db][qb];
#pragma unroll
            for (int qb = 0; qb < 4; ++qb) *(LAS float*)(xch + 16384 + (qb * 64 + lane) * 4) = lsum[qb];
        }
        asm volatile("s_waitcnt lgkmcnt(0)\n\ts_barrier" ::: "memory");
        if constexpr (LEAD) {
            float inv[4];
#pragma unroll
            for (int qb = 0; qb < 4; ++qb) inv[qb] = 1.0f / (lsum[qb] + *(const LAS float*)(xch + 16384 + (qb * 64 + lane) * 4));
            LAS unsigned char* stg = shm + ATT_LDS + (wid & 3) * 8192;
#pragma unroll
            for (int dbl = 0; dbl < 4; ++dbl)
#pragma unroll
                for (int qb = 0; qb < 4; ++qb) { const f32x4 ov = o[dbl][qb] + *(const LAS f32x4*)(xch + ((dbl * 4 + qb) * 64 + lane) * 16); const int row = qb * 16 + q16;
                    u32x2 w; w.x = cvtpk(ov[0] * inv[qb], ov[1] * inv[qb]); w.y = cvtpk(ov[2] * inv[qb], ov[3] * inv[qb]);
                    *(LAS u32x2*)(stg + row * 128 + (((4 * dbl + g4) ^ ((row & 7) << 1)) << 3)) = w; }
            asm volatile("s_waitcnt lgkmcnt(0)" ::: "memory");
#pragma unroll
            for (int rr = 0; rr < 8; ++rr) { const int row = rr * 8 + (lane >> 3), ch = lane & 7;
                const u32x4 v = *(const LAS u32x4*)(stg + row * 128 + ((ch ^ (row & 7)) << 4));
                *(u32x4*)(O + (size_t)(qrow0 + qoff + row) * opitch + ch * 8) = v; }
            asm volatile("s_waitcnt lgkmcnt(0)" ::: "memory");
        }
    } else {
    const float inv[2] = {1.0f / lsum[0], 1.0f / lsum[1]};
    { LAS unsigned char* stg = shm + ATT_LDS + wid * 4096;
#pragma unroll
      for (int rnd = 0; rnd < DV / 64; ++rnd) {
#pragma unroll
        for (int dbl = 0; dbl < 4; ++dbl)
#pragma unroll
            for (int qb = 0; qb < 2; ++qb) { const f32x4 ov = o[rnd * 4 + dbl][qb]; const int row = qb * 16 + q16;
                u32x2 w; w.x = cvtpk(ov[0] * inv[qb], ov[1] * inv[qb]); w.y = cvtpk(ov[2] * inv[qb], ov[3] * inv[qb]);
                *(LAS u32x2*)(stg + row * 128 + (((4 * dbl + g4) ^ ((row & 7) << 1)) << 3)) = w; }
        asm volatile("s_waitcnt lgkmcnt(0)" ::: "memory");
#pragma unroll
        for (int rr = 0; rr < 4; ++rr) { const int row = rr * 8 + (lane >> 3), ch = lane & 7;
            const u32x4 v = *(const LAS u32x4*)(stg + row * 128 + ((ch ^ (row & 7)) << 4));
            *(u32x4*)(O + (size_t)(qrow0 + wid * 32 + row) * opitch + rnd * 64 + ch * 8) = v; }
        asm volatile("s_waitcnt lgkmcnt(0)" ::: "memory");
      } }
    }
    asm volatile("s_waitcnt lgkmcnt(0)\n\ts_barrier" ::: "memory");
#undef ATT_DMA_K
#undef ATT_DMA_V
#undef ATT_KLOAD
#undef ATT_QK
#undef ATT_VLOAD
#undef ATT_PVP
#undef ATT_EXP
#undef ATT_SUMPACK
}
template <int DQK, int DV>
__device__ __forceinline__ void attn_unit(const bf16_t* Q, int qpitch, const bf16_t* K, int kpitch, const bf16_t* KR, const bf16_t* Vt, bf16_t* O, int opitch,
                                          int qrow0, int krow0, int NT, LAS unsigned char* shm, const float* qgain, const f32x2* rope, int tq0) {
    if (__builtin_amdgcn_readfirstlane(threadIdx.x >> 6) < 4) attn_unit_impl<DQK, DV, true>(Q, qpitch, K, kpitch, KR, Vt, O, opitch, qrow0, krow0, NT, shm, qgain, rope, tq0);
    else attn_unit_impl<DQK, DV, false>(Q, qpitch, K, kpitch, KR, Vt, O, opitch, qrow0, krow0, NT, shm, qgain, rope, tq0);
}
#undef ATT_SB
}

struct Args { const float GAS* in[25]; float GAS* out; unsigned char GAS* ws; };
typedef const Args __attribute__((address_space(4)))* KArgs;
__device__ __forceinline__ KArgs launder(KArgs p) { asm volatile("" : "+s"(p)); return p; }
__device__ __forceinline__ const float* IN(KArgs a, int i) { return (const float*)a->in[i]; }
__device__ __forceinline__ float* OUTP(KArgs a) { return (float*)a->out; }
__device__ __forceinline__ unsigned char* WSP(KArgs a) { return (unsigned char*)a->ws; }
enum { I_X = 0, I_C, I_CTX, I_CCTX, I_WADA, I_BADA, I_NMIX, I_NFFN, I_WINE, I_AQK, I_DLAM, I_ASUB, I_BQK, I_WOUTE, I_WINO, I_QNORM, I_WQUP, I_KVNORM, I_WKVUP, I_QKNORM, I_WOUTO, I_WROUTER, I_WG, I_WU, I_WDN };
constexpr int CW_BAR = 4096;

struct Frame {
    LAS unsigned char* lds;
    int tid, lane, wave, vcu, G, gw, NGW;
};

__device__ __forceinline__ void ph_fence(Frame& F) {
    asm volatile("" : "+v"(F.tid));
    F.lane = F.tid & 63; F.wave = __builtin_amdgcn_readfirstlane(F.tid >> 6);
    asm volatile("" : "+s"(F.G), "+s"(F.vcu));
    F.gw = F.vcu * NWAVES + F.wave; F.NGW = F.G * NWAVES;
}
__device__ __forceinline__ float* xrow_ptr(float* xl, float* xc, int b, int t) { return (t < SEQ) ? xl + ((size_t)(b * SEQ + t)) * DM : xc + ((size_t)(b * CTXL + (t - SEQ))) * DM; }

__device__ __forceinline__ void transpose_item(const float* W, int ldw, int k0, int n0, bf16_t* dstrow0, int ldt, LAS float* scr, int lane) {
#pragma unroll 8
    for (int i = 0; i < 32; ++i) { const int kk = 2 * i + (lane >> 5); scr[kk * 33 + (lane & 31)] = W[(size_t)(k0 + kk) * ldw + n0 + (lane & 31)]; }
    LDS_WAIT(); asm volatile("" ::: "memory");
    const int c = lane & 7;
#pragma unroll
    for (int j = 0; j < 4; ++j) { const int n = (lane >> 3) + 8 * j; const LAS float* s = scr + (8 * c) * 33 + n;
        u32x4 o; o.x = cvtpk(s[0 * 33], s[1 * 33]); o.y = cvtpk(s[2 * 33], s[3 * 33]); o.z = cvtpk(s[4 * 33], s[5 * 33]); o.w = cvtpk(s[6 * 33], s[7 * 33]);
        *(u32x4*)(dstrow0 + (size_t)n * ldt + k0 + 8 * c) = o; }
    LDS_WAIT(); asm volatile("" ::: "memory");
}

__device__ __forceinline__ void p0_phase(Frame& F, KArgs a) {
    ph_fence(F);
    unsigned char* ws = WSP(a);
    float* MOD = (float*)(ws + WS_MOD);
    LAS float* sc = (LAS float*)F.lds;
    LAS float* part = (LAS float*)(F.lds + 40960);
    for (int i = F.tid; i < 9 * 1024; i += 512) { const float v = (i < 8192) ? IN(a, I_C)[i] : IN(a, I_CCTX)[i - 8192]; sc[i] = v / (1.f + __expf(-v)); }
    __syncthreads();
    for (int it = blockIdx.x; it < 4 * 96; it += F.G) {
        const int L = it / 96, cb = it - L * 96, col = cb * 64 + F.lane;
        const float* wp = IN(a, I_WADA) + (size_t)L * 1024 * 6144 + col;
        float acc[9];
#pragma unroll
        for (int s = 0; s < 9; ++s) acc[s] = 0.f;
        const int kb = F.wave * 128;
#pragma unroll 2
        for (int k = 0; k < 128; k += 4) {
            float w[4];
#pragma unroll
            for (int j = 0; j < 4; ++j) w[j] = wp[(size_t)(kb + k + j) * 6144];
#pragma unroll
            for (int s = 0; s < 9; ++s) { const f32x4 sv = *(const LAS f32x4*)(sc + s * 1024 + kb + k); acc[s] += sv[0] * w[0] + sv[1] * w[1] + sv[2] * w[2] + sv[3] * w[3]; }
        }
#pragma unroll
        for (int s = 0; s < 9; ++s) part[(F.wave * 9 + s) * 64 + F.lane] = acc[s];
        __syncthreads();
        for (int i = F.tid; i < 9 * 64; i += 512) { const int s = i >> 6, l = i & 63; float v = 0.f;
#pragma unroll
            for (int w = 0; w < 8; ++w) v += part[(w * 9 + s) * 64 + l];
            const int cc = cb * 64 + l;
            MOD[((size_t)(L * 9 + s) * 6) * 1024 + cc] = v + IN(a, I_BADA)[L * 6144 + cc]; }
        __syncthreads();
    }
    { float* r64 = (float*)(ws + WS_ROPE64); float* r32t = (float*)(ws + WS_ROPE32);
      for (int i = blockIdx.x * 512 + F.tid; i < 128 * 16 + 128 * 8; i += F.G * 512) {
          if (i < 2048) { const int pos = i >> 4, j = i & 15; const float f = powf(10000.f, -(float)j / 16.f); const float ang = (float)pos * f; r64[2 * i] = cosf(ang); r64[2 * i + 1] = sinf(ang); }
          else { const int q = i - 2048, pos = q >> 3, j = q & 7; const float f = powf(10000.f, -(float)j / 8.f); const float ang = (float)pos * f; r32t[2 * q] = cosf(ang); r32t[2 * q + 1] = sinf(ang); } } }
    { bf16_t* wqk = (bf16_t*)(ws + WS_WQK); bf16_t* wve = (bf16_t*)(ws + WS_WVE); bf16_t* wino = (bf16_t*)(ws + WS_WINO); bf16_t* wkn = (bf16_t*)(ws + WS_WKN); bf16_t* wvo = (bf16_t*)(ws + WS_WVO);
      const int gt = blockIdx.x * 512 + F.tid, NT_ = F.G * 512; const u32x4 z = {0u, 0u, 0u, 0u};
      for (int i = gt; i < 2 * 128 * 128; i += NT_) { const int j = i / (128 * 128), q = i - j * 128 * 128; *(u32x4*)(wqk + ((size_t)j * QKW + 1664) * 1024 + q * 8) = z; *(u32x4*)(wve + ((size_t)j * VEW + 640) * 1024 + q * 8) = z; }
      for (int i = gt; i < 2 * 96 * 128; i += NT_) { const int j = i / (96 * 128), q = i - j * 96 * 128; *(u32x4*)(wino + ((size_t)j * 512 + 416) * 1024 + q * 8) = z; }
      for (int i = gt; i < 2 * 1024 * 16; i += NT_) { const int row = i >> 4, q = i & 15; *(u32x4*)(wkn + (size_t)row * 256 + 128 + q * 8) = z; *(u32x4*)(wvo + (size_t)row * 256 + 128 + q * 8) = z; } }
    LAS float* scr = (LAS float*)(F.lds + 61440 + F.wave * 8448);
    constexpr int IE_IN = 16 * 72, IE_OUT = 16 * 32, IO_IN = 16 * 13, IO_QUP = 4 * 48, IO_KV = 2 * 64, IO_OUT = 16 * 32;
    constexpr int PER_J = IE_IN + IE_OUT + IO_IN + IO_QUP + IO_KV + IO_OUT;
    for (int it = F.gw; it < 2 * PER_J; it += F.NGW) {
        const int j = it / PER_J; int r = it - j * PER_J;
        if (r < IE_IN) { const int kb = r / 72, nb = r - kb * 72, n0 = nb * 32;
            bf16_t* dst;
            if (n0 < 1024) dst = (bf16_t*)(ws + WS_WQK) + ((size_t)j * QKW + n0) * 1024;
            else if (n0 < 1536) dst = (bf16_t*)(ws + WS_WVE) + ((size_t)j * VEW + (n0 - 1024)) * 1024;
            else if (n0 < 2176) dst = (bf16_t*)(ws + WS_WQK) + ((size_t)j * QKW + 1024 + (n0 - 1536)) * 1024;
            else dst = (bf16_t*)(ws + WS_WVE) + ((size_t)j * VEW + 512 + (n0 - 2176)) * 1024;
            transpose_item(IN(a, I_WINE) + (size_t)j * 1024 * 2304, 2304, kb * 64, n0, dst, 1024, scr, F.lane); continue; } r -= IE_IN;
        if (r < IE_OUT) { const int kb = r / 32, nb = r - kb * 32;
            transpose_item(IN(a, I_WOUTE) + (size_t)j * 1024 * 1024, 1024, kb * 64, nb * 32, (bf16_t*)(ws + WS_WOE) + ((size_t)j * 1024 + nb * 32) * 1024, 1024, scr, F.lane); continue; } r -= IE_OUT;
        if (r < IO_IN) { const int kb = r / 13, nb = r - kb * 13;
            transpose_item(IN(a, I_WINO) + (size_t)j * 1024 * 416, 416, kb * 64, nb * 32, (bf16_t*)(ws + WS_WINO) + ((size_t)j * 512 + nb * 32) * 1024, 1024, scr, F.lane); continue; } r -= IO_IN;
        if (r < IO_QUP) { const int kb = r / 48, nb = r - kb * 48;
            transpose_item(IN(a, I_WQUP) + (size_t)j * 256 * 1536, 1536, kb * 64, nb * 32, (bf16_t*)(ws + WS_WQUP) + ((size_t)j * 1536 + nb * 32) * 256, 256, scr, F.lane); continue; } r -= IO_QUP;
        if (r < IO_KV) { const int kb = r / 64, nb = r - kb * 64, n0 = nb * 32, h = n0 >> 7, w = n0 & 127;
            bf16_t* dst = (w < 64) ? (bf16_t*)(ws + WS_WKN) + ((size_t)j * 1024 + h * 64 + w) * 256 : (bf16_t*)(ws + WS_WVO) + ((size_t)j * 1024 + h * 64 + (w - 64)) * 256;
            transpose_item(IN(a, I_WKVUP) + (size_t)j * 128 * 2048, 2048, kb * 64, n0, dst, 256, scr, F.lane); continue; } r -= IO_KV;
        { const int kb = r / 32, nb = r - kb * 32;
            transpose_item(IN(a, I_WOUTO) + (size_t)j * 1024 * 1024, 1024, kb * 64, nb * 32, (bf16_t*)(ws + WS_WOO) + ((size_t)j * 1024 + nb * 32) * 1024, 1024, scr, F.lane); }
    }
}
__device__ __forceinline__ void convert_experts(Frame& F, KArgs a, int L) {
    ph_fence(F);
    LAS float* scr = (LAS float*)(F.lds + 61440 + F.wave * 8448);
    bf16_t* wgu = (bf16_t*)(WSP(a) + WS_WGU); bf16_t* wd = (bf16_t*)(WSP(a) + WS_WD);
    for (int it = F.gw; it < 3 * 8192; it += F.NGW) {
        const int which = it >> 13, r = it & 8191, e = r >> 9, q = r & 511, kb = q >> 5, nb = q & 31, n0 = nb * 32;
        const float* src = IN(a, which == 0 ? I_WG : (which == 1 ? I_WU : I_WDN)) + ((size_t)(L * 16 + e)) * 1024 * 1024;
        bf16_t* dst = (which == 2) ? wd + ((size_t)e * 1024 + n0) * 1024 : wgu + ((size_t)e * 2048 + (n0 >> 7) * 256 + (n0 & 127) + (which == 1 ? 128 : 0)) * 1024;
        transpose_item(src, 1024, kb * 64, n0, dst, 1024, scr, F.lane);
    }
}

__device__ __forceinline__ void norm1_phase(Frame& F, KArgs a, int L) {
    ph_fence(F);
    unsigned char* ws = WSP(a);
    float* xl = OUTP(a); float* xc = (float*)(ws + WS_XCTX);
    const float* MOD = (const float*)(ws + WS_MOD);
    bf16_t* H = (bf16_t*)(ws + WS_H);
    const float* AFF = (const float*)(ws + WS_AFF); const int* SLOT = (const int*)(ws + WS_SLOT); const bf16_t* Y = (const bf16_t*)(ws + WS_Y);
    const float* xin = IN(a, I_X); const float* cin = IN(a, I_CTX); const float* gnm = IN(a, I_NMIX) + (L < 4 ? L : 0) * 1024;
    const int lane = F.lane;
    constexpr int RB = 2;
    for (int r0 = F.gw; r0 < NR; r0 += RB * F.NGW) {
        f32x4 v[RB][4]; int sl[RB]; float af[RB]; float* xr[RB]; bool ok[RB]; int ss[RB], rw[RB];
#pragma unroll
        for (int k = 0; k < RB; ++k) {
            int r = r0 + k * F.NGW; ok[k] = r < NR; if (!ok[k]) r = r0;
            const int b = r / TPS, t = r - b * TPS; const bool isctx = t >= SEQ; ss[k] = isctx ? 8 : b; rw[k] = r;
            if (L == 4 && isctx) ok[k] = false;
            xr[k] = xrow_ptr(xl, xc, b, t);
            const float* src = (L == 0) ? (isctx ? cin + ((size_t)(b * CTXL + t - SEQ)) * DM : xin + ((size_t)(b * SEQ + t)) * DM) : xr[k];
#pragma unroll
            for (int j = 0; j < 4; ++j) v[k][j] = *(const f32x4*)(src + 256 * j + 4 * lane);
            sl[k] = -1; af[k] = 0.f;
            if (L > 0 && lane < 16) { sl[k] = SLOT[(size_t)r * 16 + lane]; af[k] = AFF[(size_t)r * 16 + lane]; }
        }
#pragma unroll
        for (int k = 0; k < RB; ++k) {
            if (!ok[k]) continue;
            if (L > 0) {
                f32x4 acc[4];
#pragma unroll
                for (int j = 0; j < 4; ++j) acc[j] = (f32x4){0.f, 0.f, 0.f, 0.f};
                unsigned mask = (unsigned)__ballot(sl[k] >= 0) & 0xffffu;
                while (mask) {
                    int pq[4]; float gq[4];
#pragma unroll
                    for (int q = 0; q < 4; ++q) {
                        if (mask) { const int e = __builtin_ctz(mask); mask &= mask - 1u; pq[q] = __builtin_amdgcn_readlane(sl[k], e); gq[q] = __uint_as_float(__builtin_amdgcn_readlane(__float_as_uint(af[k]), e)); }
                        else { pq[q] = pq[0]; gq[q] = 0.f; }
                    }
                    u32x2 y[4][4];
#pragma unroll
                    for (int q = 0; q < 4; ++q)
#pragma unroll
                        for (int j = 0; j < 4; ++j) y[q][j] = *(const u32x2*)(Y + (size_t)pq[q] * DM + 256 * j + 4 * lane);
#pragma unroll
                    for (int q = 0; q < 4; ++q)
#pragma unroll
                        for (int j = 0; j < 4; ++j) { acc[j][0] += gq[q] * bf_lo(y[q][j].x); acc[j][1] += gq[q] * bf_hi(y[q][j].x); acc[j][2] += gq[q] * bf_lo(y[q][j].y); acc[j][3] += gq[q] * bf_hi(y[q][j].y); }
                }
                const float* m5 = MOD + ((size_t)((L - 1) * 9 + ss[k]) * 6 + 5) * 1024;
#pragma unroll
                for (int j = 0; j < 4; ++j) v[k][j] += *(const f32x4*)(m5 + 256 * j + 4 * lane) * acc[j];
            }
#pragma unroll
            for (int j = 0; j < 4; ++j) *(f32x4*)(xr[k] + 256 * j + 4 * lane) = v[k][j];
            if (L == 4) continue;
            float sq = 0.f;
#pragma unroll
            for (int j = 0; j < 4; ++j) sq += (v[k][j][0] * v[k][j][0] + v[k][j][1] * v[k][j][1]) + (v[k][j][2] * v[k][j][2] + v[k][j][3] * v[k][j][3]);
            const float rstd = rsqrtf(wave_sum(sq) * (1.f / DM) + EPS);
            const float* sh = MOD + ((size_t)(L * 9 + ss[k]) * 6 + 0) * 1024; const float* scl = sh + 1024;
            bf16_t* hr = H + (size_t)rw[k] * DM;
#pragma unroll
            for (int j = 0; j < 4; ++j) { const int c = 256 * j + 4 * lane; const f32x4 g = *(const f32x4*)(gnm + c), sf = *(const f32x4*)(sh + c), sc = *(const f32x4*)(scl + c);
                f32x4 h = (v[k][j] * rstd) * g * (sc + 1.f) + sf; u32x2 w; w.x = cvtpk(h[0], h[1]); w.y = cvtpk(h[2], h[3]); *(u32x2*)(hr + c) = w; }
            asm volatile("" ::: "memory");
        }
    }
}

__device__ __forceinline__ void build_router_mod(Frame& F, KArgs a, int L) {
    unsigned char* ws = WSP(a);
    const float* MOD = (const float*)(ws + WS_MOD); const float* wr = IN(a, I_WROUTER) + (size_t)L * 1024 * 16; const float* gn = IN(a, I_NFFN) + L * 1024;
    float* WP = (float*)(ws + WS_WP); float* BI = WP + 9 * 16384;
    for (int idx = F.gw * 64 + F.lane; idx < 9 * 16384; idx += F.NGW * 64) {
        const int s_ = idx >> 14, rem = idx & 16383, i = rem & 3, e = (rem >> 2) & 15, kq = (rem >> 6) & 3, j = rem >> 8, k = 16 * j + 4 * kq + i;
        const float* scl = MOD + ((size_t)(L * 9 + s_) * 6 + 4) * 1024;
        WP[idx] = wr[k * 16 + e] * gn[k] * (1.f + scl[k]); }
    for (int d = F.gw; d < 144; d += F.NGW) { const int s_ = d >> 4, e = d & 15; const float* sh = MOD + ((size_t)(L * 9 + s_) * 6 + 3) * 1024;
        float p = 0.f;
        for (int k = F.lane; k < 1024; k += 64) p += sh[k] * wr[k * 16 + e];
        p = wave_sum(p); if (F.lane == 0) BI[d] = p; }
}
__device__ __forceinline__ void norm2_block(float* xl, float* xc, const float* MOD, const float* gn, const float* WP, bf16_t* H, float* AFF, int L, int row0, int nrows, int lane) {
    const int r16 = lane & 15, kq = lane >> 4;
    const int b = row0 / TPS, t0 = row0 - b * TPS; const int s_ = (t0 >= SEQ) ? 8 : b;
    if (L == 3 && t0 >= SEQ) return;
    const int rl = (r16 < nrows) ? r16 : r16 - nrows;
    const float* xr = xrow_ptr(xl, xc, b, t0 + rl) + 4 * kq;
    const float* wp = WP + s_ * 16384 + (kq * 16 + r16) * 4;
    f32x4 acc = {0.f, 0.f, 0.f, 0.f}; float sq = 0.f;
    f32x4 xa[8], wb[8];
#pragma unroll
    for (int q = 0; q < 8; ++q) { xa[q] = *(const f32x4*)(xr + 16 * q); wb[q] = *(const f32x4*)(wp + 256 * q); }
#pragma unroll
    for (int g = 0; g < 8; ++g) {
        f32x4 xn[8], wn[8];
        if (g < 7) {
#pragma unroll
            for (int q = 0; q < 8; ++q) { xn[q] = *(const f32x4*)(xr + 16 * (8 * (g + 1) + q)); wn[q] = *(const f32x4*)(wp + 256 * (8 * (g + 1) + q)); } }
#pragma unroll
        for (int q = 0; q < 8; ++q) {
            sq += (xa[q][0] * xa[q][0] + xa[q][1] * xa[q][1]) + (xa[q][2] * xa[q][2] + xa[q][3] * xa[q][3]);
#pragma unroll
            for (int i = 0; i < 4; ++i) acc = __builtin_amdgcn_mfma_f32_16x16x4f32(xa[q][i], wb[q][i], acc, 0, 0, 0); }
        if (g < 7) {
#pragma unroll
            for (int q = 0; q < 8; ++q) { xa[q] = xn[q]; wb[q] = wn[q]; } }
    }
    sq = att::lanes4_sum(sq);
    const float rstd = rsqrtf(sq * (1.f / DM) + EPS);
    const float bias = WP[9 * 16384 + s_ * 16 + r16];
#pragma unroll
    for (int i = 0; i < 4; ++i) {
        const float rs = __shfl(rstd, 4 * kq + i);
        const float lg = acc[i] * rs + bias;
        float mx = lg;
#pragma unroll
        for (int o = 1; o < 16; o <<= 1) mx = fmaxf(mx, __shfl_xor(mx, o));
        const float mine = __expf(lg - mx); float den = mine;
#pragma unroll
        for (int o = 1; o < 16; o <<= 1) den += __shfl_xor(den, o);
        if (4 * kq + i < nrows) AFF[(size_t)(row0 + 4 * kq + i) * 16 + r16] = mine / den;
    }
    const float* sh = MOD + ((size_t)(L * 9 + s_) * 6 + 3) * 1024; const float* scl = sh + 1024;
    f32x4 mg[4], sf[4];
#pragma unroll
    for (int j = 0; j < 4; ++j) { const int c = 256 * j + 4 * lane; mg[j] = *(const f32x4*)(gn + c) * (*(const f32x4*)(scl + c) + 1.f); sf[j] = *(const f32x4*)(sh + c); }
#pragma unroll
    for (int r4 = 0; r4 < 4; ++r4) {
        if (r4 * 4 < nrows) {
            f32x4 v[4][4];
#pragma unroll
            for (int k = 0; k < 4; ++k) { const float* xq = xrow_ptr(xl, xc, b, t0 + r4 * 4 + k);
#pragma unroll
                for (int j = 0; j < 4; ++j) v[k][j] = *(const f32x4*)(xq + 256 * j + 4 * lane); }
#pragma unroll
            for (int k = 0; k < 4; ++k) { const float rs = __builtin_bit_cast(float, __builtin_amdgcn_readlane(__builtin_bit_cast(int, rstd), r4 * 4 + k));
                bf16_t* hr = H + (size_t)(row0 + r4 * 4 + k) * DM;
#pragma unroll
                for (int j = 0; j < 4; ++j) { const f32x4 h = (v[k][j] * rs) * mg[j] + sf[j]; u32x2 w; w.x = cvtpk(h[0], h[1]); w.y = cvtpk(h[2], h[3]); *(u32x2*)(hr + 256 * j + 4 * lane) = w; } }
            asm volatile("" ::: "memory");
        }
    }
}
__device__ __forceinline__ void norm2_router_phase(Frame& F, KArgs a, int L) {
    ph_fence(F);
    unsigned char* ws = WSP(a);
    float* xl = OUTP(a); float* xc = (float*)(ws + WS_XCTX);
    const float* MOD = (const float*)(ws + WS_MOD); const float* WP = (const float*)(ws + WS_WP);
    bf16_t* H = (bf16_t*)(ws + WS_H); float* AFF = (float*)(ws + WS_AFF);
    const float* gn = IN(a, I_NFFN) + L * 1024;
    constexpr int NBLK = NR / 16;
    const int nfull = (NBLK / F.NGW) * F.NGW;
    if (F.wave == 0)
        for (int hb = F.vcu; hb < 2 * (NBLK - nfull); hb += F.G) norm2_block(xl, xc, MOD, gn, WP, H, AFF, L, nfull * 16 + hb * 8, 8, F.lane);
    for (int blk = nfull - 1 - F.gw; blk >= 0; blk -= F.NGW) norm2_block(xl, xc, MOD, gn, WP, H, AFF, L, blk * 16, 16, F.lane);
}

__device__ __forceinline__ void topk_phase(Frame& F, KArgs a, int nsets) {
    ph_fence(F);
    unsigned char* ws = WSP(a);
    const float* AFF = (const float*)(ws + WS_AFF); int* SLOT = (int*)(ws + WS_SLOT); int* TOK = (int*)(ws + WS_TOK);
    LAS unsigned* keys = (LAS unsigned*)F.lds;
    LAS unsigned* hist = keys + 8192;
    LAS unsigned* misc = hist + 256;
    LAS unsigned* wtot = misc + 8;
    const int tid = F.tid, lane = F.lane;
    for (int sidx = blockIdx.x; sidx < nsets; sidx += F.G) {
        const bool lat = sidx < 128; const int k = lat ? sidx : sidx - 128, b = k >> 4, e = k & 15;
        const int row0 = b * TPS + (lat ? 0 : SEQ), n = lat ? SEQ : CTXL, cap = lat ? CAP_L : CAP_C;
        const int pairbase = lat ? (b * 16 + e) * CAP_L : NPAIR_L + e * (NB * CAP_C) + b * CAP_C;
        for (int i = tid; i < n; i += 512) keys[i] = __float_as_uint(AFF[(size_t)(row0 + i) * 16 + e]);
        if (tid == 0) { misc[0] = 0u; misc[1] = (unsigned)cap; }
        __syncthreads();
        for (int round = 0; round < 4; ++round) {
            const int shift = 24 - 8 * round;
            if (tid < 256) hist[tid] = 0u;
            __syncthreads();
            const unsigned prefix = misc[0], need = misc[1];
            for (int i = tid; i < n; i += 512) { const unsigned kk = keys[i]; if (round == 0 || (kk >> (shift + 8)) == prefix) atomicAdd((unsigned*)&hist[(kk >> shift) & 255u], 1u); }
            __syncthreads();
            if (tid < 64) {
                unsigned h[4]; unsigned ssum = 0u;
#pragma unroll
                for (int j = 0; j < 4; ++j) { h[j] = hist[255 - 4 * lane - j]; ssum += h[j]; }
                unsigned incl = ssum;
#pragma unroll
                for (int o = 1; o < 64; o <<= 1) { const unsigned tt = __shfl_up(incl, o); if (lane >= o) incl += tt; }
                unsigned c = incl - ssum;
#pragma unroll
                for (int j = 0; j < 4; ++j) { if (c < need && need <= c + h[j]) { misc[0] = (prefix << 8) | (unsigned)(255 - 4 * lane - j); misc[1] = need - c; } c += h[j]; }
            }
            __syncthreads();
        }
        const unsigned T = misc[0], need_eq = misc[1];
        const int chunk = (n + 511) / 512, i0 = tid * chunk;
        unsigned cg = 0u, ce = 0u;
        for (int i = 0; i < chunk; ++i) { const int idx = i0 + i; if (idx < n) { const unsigned kk = keys[idx]; cg += (kk > T) ? 1u : 0u; ce += (kk == T) ? 1u : 0u; } }
        const unsigned packed = cg | (ce << 16);
        unsigned incl = packed;
#pragma unroll
        for (int o = 1; o < 64; o <<= 1) { const unsigned tt = __shfl_up(incl, o); if (lane >= o) incl += tt; }
        if (lane == 63) wtot[F.wave] = incl;
        __syncthreads();
        unsigned wbase = 0u;
        for (int w = 0; w < F.wave; ++w) wbase += wtot[w];
        const unsigned excl = wbase + incl - packed;
        unsigned g = excl & 0xffffu, q = excl >> 16;
        for (int i = 0; i < chunk; ++i) { const int idx = i0 + i; if (idx < n) { const unsigned kk = keys[idx]; int slot = -1;
                if (kk > T) { slot = (int)(g + (q < need_eq ? q : need_eq)); ++g; }
                else if (kk == T) { if (q < need_eq) slot = (int)(g + q); ++q; }
                const int row = row0 + idx;
                if (slot >= 0) { TOK[pairbase + slot] = row; SLOT[(size_t)row * 16 + e] = pairbase + slot; } else SLOT[(size_t)row * 16 + e] = -1; } }
        __syncthreads();
    }
}

__device__ __forceinline__ void even_qk_phase(Frame& F, KArgs a, int j) {
    ph_fence(F);
    unsigned char* ws = WSP(a);
    bf16_t* QK = (bf16_t*)(ws + WS_QK); const f32x2* R64 = (const f32x2*)(ws + WS_ROPE64);
    const float* aqk = IN(a, I_AQK) + j * 128; const float* bqk = IN(a, I_BQK) + j * 128;
    const int lane = F.lane, q4 = lane & 3, hl = lane >> 2;
    const int d1 = (q4 >> 1) * 32 + (q4 & 1) * 8, d2 = d1 + 16;
    const bool hact = hl < 10; const int hc = hl < 8 ? 8 + hl : (hl < 10 ? 16 + hl : 8);
    const float* gain = (hc < 16) ? aqk + 64 : bqk + 64;
    float g1[8], g2[8];
#pragma unroll
    for (int i = 0; i < 8; ++i) { g1[i] = gain[d1 + i]; g2[i] = gain[d2 + i]; }
    constexpr int RB = 4;
    for (int r0 = F.gw + ((NR - 1 - F.gw) / (RB * F.NGW)) * (RB * F.NGW); r0 >= 0; r0 -= RB * F.NGW) {
        u32x4 w1[RB], w2[RB]; bool ok[RB]; int tt[RB]; bf16_t* rowp[RB];
#pragma unroll
        for (int k = 0; k < RB; ++k) {
            int r = r0 + k * F.NGW; ok[k] = r < NR; if (!ok[k]) r = r0;
            const int b = r / TPS; tt[k] = r - b * TPS; rowp[k] = QK + (size_t)r * QKW + hc * 64;
            w1[k] = *(const u32x4*)(rowp[k] + d1); w2[k] = *(const u32x4*)(rowp[k] + d2);
        }
#pragma unroll
        for (int k = 0; k < RB; ++k) {
            const int t = tt[k]; const bool lat = t < SEQ; const int pos = (q4 >> 1) ? (t & 63) : (t >> 6);
            float x1[8], x2[8];
#pragma unroll
            for (int i = 0; i < 4; ++i) { x1[2 * i] = bf_lo(w1[k][i]); x1[2 * i + 1] = bf_hi(w1[k][i]); x2[2 * i] = bf_lo(w2[k][i]); x2[2 * i + 1] = bf_hi(w2[k][i]); }
            float ss = 0.f;
#pragma unroll
            for (int i = 0; i < 8; ++i) ss += x1[i] * x1[i] + x2[i] * x2[i];
            ss += __shfl_xor(ss, 1); ss += __shfl_xor(ss, 2);
            const float rstd = rsqrtf(ss * (1.f / 64.f) + EPS);
            float o1[8], o2[8];
#pragma unroll
            for (int i = 0; i < 8; ++i) {
                const float a1 = x1[i] * rstd * g1[i], a2 = x2[i] * rstd * g2[i];
                float c = 1.f, s_ = 0.f;
                if (lat) { const f32x2 cs = R64[pos * 16 + (q4 & 1) * 8 + i]; c = cs.x; s_ = cs.y; }
                o1[i] = a1 * c - a2 * s_; o2[i] = a2 * c + a1 * s_;
            }
            if (hact && ok[k]) { u32x4 u1, u2;
#pragma unroll
                for (int i = 0; i < 4; ++i) { u1[i] = cvtpk(o1[2 * i], o1[2 * i + 1]); u2[i] = cvtpk(o2[2 * i], o2[2 * i + 1]); }
                *(u32x4*)(rowp[k] + d1) = u1; *(u32x4*)(rowp[k] + d2) = u2; }
        }
    }
}
__device__ __forceinline__ void even_merge_phase(Frame& F, KArgs a, int j, int layer) {
    ph_fence(F);
    unsigned char* ws = WSP(a);
    const bf16_t* OB = (const bf16_t*)(ws + WS_OB); bf16_t* H = (bf16_t*)(ws + WS_H);
    const float lam_init = 0.8f - 0.6f * expf(-0.3f * (float)layer);
    const float* lv = IN(a, I_DLAM) + j * 256;
    const float s01 = wave_sum(lv[F.lane] * lv[64 + F.lane]), s23 = wave_sum(lv[128 + F.lane] * lv[192 + F.lane]);
    const float lam = expf(s01) - expf(s23) + lam_init;
    const float* sub = IN(a, I_ASUB) + j * 128;
    const int lane = F.lane, hd = lane >> 4, sb = lane & 15;
    float gsub[8];
#pragma unroll
    for (int i = 0; i < 8; ++i) gsub[i] = sub[sb * 8 + i] * (1.f - lam_init);
    constexpr int RB = 4;
    for (int r0 = F.gw; r0 < NR; r0 += RB * F.NGW) {
        u32x4 w1[RB], w2[RB]; bool ok[RB]; int rw[RB];
#pragma unroll
        for (int k = 0; k < RB; ++k) { int r = r0 + k * F.NGW; ok[k] = r < NR; if (!ok[k]) r = r0; rw[k] = r;
            const bf16_t* p1 = OB + (size_t)r * 1024 + (hd * 2) * 128 + sb * 8; w1[k] = *(const u32x4*)p1; w2[k] = *(const u32x4*)(p1 + 128); }
#pragma unroll
        for (int k = 0; k < RB; ++k) {
            float v[8]; float ss = 0.f;
#pragma unroll
            for (int i = 0; i < 4; ++i) { v[2 * i] = bf_lo(w1[k][i]) - lam * bf_lo(w2[k][i]); v[2 * i + 1] = bf_hi(w1[k][i]) - lam * bf_hi(w2[k][i]); }
#pragma unroll
            for (int i = 0; i < 8; ++i) ss += v[i] * v[i];
            ss += __shfl_xor(ss, 1); ss += __shfl_xor(ss, 2); ss += __shfl_xor(ss, 4); ss += __shfl_xor(ss, 8);
            const float rstd = rsqrtf(ss * (1.f / 128.f) + EPS);
            u32x4 u;
#pragma unroll
            for (int i = 0; i < 4; ++i) u[i] = cvtpk(v[2 * i] * rstd * gsub[2 * i], v[2 * i + 1] * rstd * gsub[2 * i + 1]);
            if (ok[k]) *(u32x4*)(H + (size_t)rw[k] * 1024 + hd * 128 + sb * 8) = u;
        }
    }
}
__device__ __forceinline__ void odd_c_phase(Frame& F, KArgs a, int j) {
    ph_fence(F);
    unsigned char* ws = WSP(a);
    const float* CR = (const float*)(ws + WS_CRAW); bf16_t* CN = (bf16_t*)(ws + WS_CN); bf16_t* KR = (bf16_t*)(ws + WS_KR); const f32x2* R32 = (const f32x2*)(ws + WS_ROPE32);
    const float* qn = IN(a, I_QNORM) + j * 256; const float* kvn = IN(a, I_KVNORM) + j * 128; const float* qkn = IN(a, I_QKNORM) + j * 192;
    const int lane = F.lane;
    const f32x4 gq = *(const f32x4*)(qn + 4 * lane); const f32x2 gkv = *(const f32x2*)(kvn + 2 * lane); const float gkr = qkn[96 + 64 + (lane & 31)];
    constexpr int RB = 4;
    for (int r0 = F.gw; r0 < NR; r0 += RB * F.NGW) {
        f32x4 cq[RB]; f32x2 ckv[RB]; float kr[RB]; bool ok[RB]; int rw[RB];
#pragma unroll
        for (int k = 0; k < RB; ++k) { int r = r0 + k * F.NGW; ok[k] = r < NR; if (!ok[k]) r = r0; rw[k] = r;
            const float* cr = CR + (size_t)r * 512;
            cq[k] = *(const f32x4*)(cr + 4 * lane); ckv[k] = *(const f32x2*)(cr + 256 + 2 * lane); kr[k] = (lane < 32) ? cr[384 + lane] : 0.f; }
#pragma unroll
        for (int k = 0; k < RB; ++k) {
            const int r = rw[k]; const int b = r / TPS, t = r - b * TPS; const bool lat = t < SEQ;
            const float sq = wave_sum((cq[k][0] * cq[k][0] + cq[k][1] * cq[k][1]) + (cq[k][2] * cq[k][2] + cq[k][3] * cq[k][3]));
            const float skv = wave_sum(ckv[k][0] * ckv[k][0] + ckv[k][1] * ckv[k][1]);
            const float skr = wave_sum(kr[k] * kr[k]);
            const float rq = rsqrtf(sq * (1.f / 256.f) + EPS), rkv = rsqrtf(skv * (1.f / 128.f) + EPS), rkr = rsqrtf(skr * (1.f / 32.f) + EPS);
            bf16_t* cn = CN + (size_t)r * CNW;
            float kv = kr[k] * rkr * gkr;
            const float partner = __shfl_xor(kv, 8);
            if (lat) { const int pos = (lane & 16) ? (t & 63) : (t >> 6); const f32x2 cs = R32[pos * 8 + (lane & 7)];
                kv = (lane & 8) ? (kv * cs.x + partner * cs.y) : (kv * cs.x - partner * cs.y); }
            const float other = __shfl_down(kv, 1);
            if (ok[k]) {
                u32x2 w; w.x = cvtpk(cq[k][0] * rq * gq[0], cq[k][1] * rq * gq[1]); w.y = cvtpk(cq[k][2] * rq * gq[2], cq[k][3] * rq * gq[3]); *(u32x2*)(cn + 4 * lane) = w;
                *(unsigned*)(cn + 256 + 2 * lane) = cvtpk(ckv[k][0] * rkv * gkv[0], ckv[k][1] * rkv * gkv[1]);
                *(unsigned*)(cn + 384 + 2 * lane) = 0u;
                if (lane < 32 && !(lane & 1)) *(unsigned*)(KR + (size_t)r * 32 + lane) = cvtpk(kv, other);
            }
        }
    }
}
__device__ __forceinline__ void odd_qk_phase(Frame& F, KArgs a, int j) {
    ph_fence(F);
    unsigned char* ws = WSP(a);
    bf16_t* KN = (bf16_t*)(ws + WS_KN);
    const float* qkn = IN(a, I_QKNORM) + j * 192;
    const int lane = F.lane, q4 = lane & 3, hd = lane >> 2;
    float gkn[16];
#pragma unroll
    for (int i = 0; i < 16; ++i) gkn[i] = qkn[96 + q4 * 16 + i];
    constexpr int RB = 4;
    for (int r0 = F.gw + ((NR - 1 - F.gw) / (RB * F.NGW)) * (RB * F.NGW); r0 >= 0; r0 -= RB * F.NGW) {
        u32x4 ka[RB], kb[RB]; bool ok[RB]; bf16_t* pp[RB];
#pragma unroll
        for (int k = 0; k < RB; ++k) { int r = r0 + k * F.NGW; ok[k] = r < NR; if (!ok[k]) r = r0;
            pp[k] = KN + (size_t)r * 1024 + hd * 64 + q4 * 16; ka[k] = *(const u32x4*)pp[k]; kb[k] = *(const u32x4*)(pp[k] + 8); }
#pragma unroll
        for (int k = 0; k < RB; ++k) {
            float x[16];
#pragma unroll
            for (int i = 0; i < 4; ++i) { x[2 * i] = bf_lo(ka[k][i]); x[2 * i + 1] = bf_hi(ka[k][i]); x[8 + 2 * i] = bf_lo(kb[k][i]); x[8 + 2 * i + 1] = bf_hi(kb[k][i]); }
            float sn = 0.f;
#pragma unroll
            for (int i = 0; i < 16; ++i) sn += x[i] * x[i];
            sn += __shfl_xor(sn, 1); sn += __shfl_xor(sn, 2);
            const float rn = rsqrtf(sn * (1.f / 64.f) + EPS);
            u32x4 u1, u2;
#pragma unroll
            for (int i = 0; i < 4; ++i) { u1[i] = cvtpk(x[2 * i] * rn * gkn[2 * i], x[2 * i + 1] * rn * gkn[2 * i + 1]); u2[i] = cvtpk(x[8 + 2 * i] * rn * gkn[8 + 2 * i], x[8 + 2 * i + 1] * rn * gkn[8 + 2 * i + 1]); }
            if (ok[k]) { *(u32x4*)pp[k] = u1; *(u32x4*)(pp[k] + 8) = u2; }
        }
    }
}

__global__ void __launch_bounds__(NWAVES * 64, 2) mega_fwd(Args args_) {
    extern __shared__ __attribute__((aligned(16))) unsigned char lds_raw[];
    KArgs kargs = (KArgs)__builtin_amdgcn_kernarg_segment_ptr();
#define a launder(kargs)
    Frame F;
    F.lds = (LAS unsigned char*)lds_raw;
    F.tid = threadIdx.x; F.lane = F.tid & 63; F.wave = __builtin_amdgcn_readfirstlane(F.tid >> 6);
    F.G = gridDim.x; { const int bx = blockIdx.x; F.vcu = (F.G % 8 == 0) ? (bx % 8) * (F.G / 8) + bx / 8 : bx; }
    F.gw = F.vcu * NWAVES + F.wave; F.NGW = F.G * NWAVES;
    unsigned char GAS* wsg = launder(kargs)->ws;
#define ws ((unsigned char*)wsg)
    volatile LAS unsigned* MISC = (volatile LAS unsigned*)(F.lds + MISC_OFF);
    for (int u = F.tid; u < (LDS_BYTES - LDSCTL_OFF) / 4; u += NWAVES * 64) ((LAS unsigned*)(F.lds + LDSCTL_OFF))[u] = 0u;
    __syncthreads();
    XcdBarrier bar = xcd_barrier_post((unsigned*)(ws + WS_CTL) + CW_BAR, MISC + 8);
#define GRID_BAR() do { asm volatile("" : "+s"(wsg)); bar.bar = (unsigned*)(ws + WS_CTL) + CW_BAR; bar.x = xb_xcc_id(); xcd_barrier(bar); asm volatile("" : "+s"(wsg)); } while (0)
#define H ((bf16_t*)(ws + WS_H))
#define xl OUTP(launder(kargs))
#define xc ((float*)(ws + WS_XCTX))
#define MOD ((const float*)(ws + WS_MOD))
    const int bx = (int)blockIdx.x;

    p0_phase(F, a);
    GRID_BAR();

    for (int L = 0; L < 4; ++L) {
        const int j = L >> 1;
        asm volatile("" : "+s"(wsg));
        norm1_phase(F, a, L);
        convert_experts(F, a, L);
        build_router_mod(F, a, L);
        GRID_BAR();
        if (!(L & 1)) {
            bf16_t* QK = (bf16_t*)(ws + WS_QK); bf16_t* VTE = (bf16_t*)(ws + WS_VTE); bf16_t* OB = (bf16_t*)(ws + WS_OB);
            { pg8::Gemm g{H, (const bf16_t*)(ws + WS_WQK) + (size_t)j * QKW * 1024, 1024, 1024, 1024, nullptr}; pg8::StaticOrder S; S.init(NR, QKW, F.G, bx);
              pg8::EpiBf16 E{QK, (size_t)QKW, 0x7fffffff}; pg8::gemm_phase<pg8::EpiBf16, pg8::StaticOrder>(F.lds, g, S, E); }
            { pg8::Gemm g{(const bf16_t*)(ws + WS_WVE) + (size_t)j * VEW * 1024, H, 1024, 1024, 1024, nullptr}; pg8::StaticOrder S; S.init(VEW, NR, F.G, (bx + F.G / 2) % F.G);
              pg8::EpiBf16 E{VTE, (size_t)NR, 0x7fffffff}; pg8::gemm_phase<pg8::EpiBf16, pg8::StaticOrder>(F.lds, g, S, E); }
            GRID_BAR();
            even_qk_phase(F, a, j);
            GRID_BAR();
            for (int i = 0;; ++i) { const int u = i * F.G + F.vcu; if (u >= 2048) break; const int sid = u >> 5, qb = u & 31, b = sid >> 3, hc = sid & 7, h = hc >> 1, c = hc & 1;
                att::attn_unit<64, 128>(QK + h * 128 + c * 64, QKW, QK + 512 + h * 128 + c * 64, QKW, nullptr, VTE + (size_t)(h * 128) * NR, OB + hc * 128, 1024, b * TPS + qb * 256, b * TPS, 132, F.lds, IN(a, I_AQK) + j * 128, (const f32x2*)(ws + WS_ROPE64), qb * 256); }
            for (int i = 0;; ++i) { const int u = i * F.G + F.vcu; if (u >= 2048) break; const int sid = u >> 5, qb = u & 31, b = sid >> 3, kvh = (sid >> 2) & 1, g = sid & 3;
                att::attn_unit<64, 64>(QK + 1024 + kvh * 256 + g * 64, QKW, QK + 1536 + kvh * 64, QKW, nullptr, VTE + (size_t)(512 + kvh * 64) * NR, H + 512 + kvh * 256 + g * 64, 1024, b * TPS + qb * 256, b * TPS, 132, F.lds, IN(a, I_BQK) + j * 128, (const f32x2*)(ws + WS_ROPE64), qb * 256); }
            if (L < 3) {
                for (int u = F.vcu; u < 64; u += F.G) { const int b = u >> 3, hc = u & 7, h = hc >> 1, c = hc & 1;
                    att::attn_unit<64, 128>(QK + h * 128 + c * 64, QKW, QK + 512 + h * 128 + c * 64, QKW, nullptr, VTE + (size_t)(h * 128) * NR, OB + hc * 128, 1024, b * TPS + SEQ, b * TPS + SEQ, 4, F.lds, IN(a, I_AQK) + j * 128, (const f32x2*)(ws + WS_ROPE64), -100000); }
                for (int u = F.vcu - 64; u < 64; u += F.G) { if (u < 0) continue; const int b = u >> 3, kvh = (u >> 2) & 1, g = u & 3;
                    att::attn_unit<64, 64>(QK + 1024 + kvh * 256 + g * 64, QKW, QK + 1536 + kvh * 64, QKW, nullptr, VTE + (size_t)(512 + kvh * 64) * NR, H + 512 + kvh * 256 + g * 64, 1024, b * TPS + SEQ, b * TPS + SEQ, 4, F.lds, IN(a, I_BQK) + j * 128, (const f32x2*)(ws + WS_ROPE64), -100000); }
            }
            GRID_BAR();
            even_merge_phase(F, a, j, L);
            GRID_BAR();
        } else {
            float* CRAW = (float*)(ws + WS_CRAW); bf16_t* CN = (bf16_t*)(ws + WS_CN); bf16_t* KR = (bf16_t*)(ws + WS_KR);
            bf16_t* Q = (bf16_t*)(ws + WS_Q); bf16_t* KN = (bf16_t*)(ws + WS_KN); bf16_t* VTO = (bf16_t*)(ws + WS_VTO);
            { pg8::Gemm g{H, (const bf16_t*)(ws + WS_WINO) + (size_t)j * 512 * 1024, 1024, 1024, 1024, nullptr}; pg8::StaticOrder S; S.init(NR, 512, F.G, bx);
              pg8::EpiF32 E{CRAW, (size_t)512}; pg8::gemm_phase<pg8::EpiF32, pg8::StaticOrder>(F.lds, g, S, E); }
            GRID_BAR();
            odd_c_phase(F, a, j);
            GRID_BAR();
            { pg8::Gemm g{CN, (const bf16_t*)(ws + WS_WQUP) + (size_t)j * 1536 * 256, CNW, 256, 256, nullptr}; pg8::StaticOrder S; if (L < 3) S.init(NR, QW, F.G, bx); else S.init(NB * SEQ, QW, F.G, bx, 1);
              pg8::EpiBf16 E{Q, (size_t)QW, 0x7fffffff}; pg8::gemm_phase<pg8::EpiBf16, pg8::StaticOrder>(F.lds, g, S, E); }
            int k128 = 128; asm volatile("" : "+s"(k128));
            { pg8::Gemm g{CN + 256, (const bf16_t*)(ws + WS_WKN) + (size_t)j * 1024 * 256, CNW, 256, k128, nullptr};     pg8::StaticOrder S; S.init(NR, 1024, F.G, (bx + F.G / 4) % F.G);
              pg8::EpiBf16 E{KN, (size_t)1024, 0x7fffffff}; pg8::gemm_phase<pg8::EpiBf16, pg8::StaticOrder>(F.lds, g, S, E); }
            { pg8::Gemm g{(const bf16_t*)(ws + WS_WVO) + (size_t)j * 1024 * 256, CN + 256, 256, CNW, k128, nullptr}; pg8::StaticOrder S; S.init(1024, NR, F.G, (bx + F.G / 2) % F.G);
              pg8::EpiBf16 E{VTO, (size_t)NR, 0x7fffffff}; pg8::gemm_phase<pg8::EpiBf16, pg8::StaticOrder>(F.lds, g, S, E); }
            GRID_BAR();
            odd_qk_phase(F, a, j);
            GRID_BAR();
            for (int i = 0;; ++i) { const int u = i * F.G + F.vcu; if (u >= 4096) break; const int sid = u >> 5, qb = u & 31, b = sid >> 4, h = sid & 15;
                att::attn_unit<96, 64>(Q + h * 96, QW, KN + h * 64, 1024, KR, VTO + (size_t)(h * 64) * NR, H + h * 64, 1024, b * TPS + qb * 256, b * TPS, 132, F.lds, IN(a, I_QKNORM) + j * 192, (const f32x2*)(ws + WS_ROPE32), qb * 256); }
            if (L < 3) {
                for (int u = F.vcu; u < 128; u += F.G) { const int b = u >> 4, h = u & 15;
                    att::attn_unit<96, 64>(Q + h * 96, QW, KN + h * 64, 1024, KR, VTO + (size_t)(h * 64) * NR, H + h * 64, 1024, b * TPS + SEQ, b * TPS + SEQ, 4, F.lds, IN(a, I_QKNORM) + j * 192, (const f32x2*)(ws + WS_ROPE32), -100000); }
            }
            GRID_BAR();
        }
        { const bf16_t* Wo = (L & 1) ? (const bf16_t*)(ws + WS_WOO) + (size_t)j * 1024 * 1024 : (const bf16_t*)(ws + WS_WOE) + (size_t)j * 1024 * 1024;
          pg8::Gemm g{H, Wo, 1024, 1024, 1024, nullptr}; pg8::StaticOrder S; if (L < 3) S.init(NR, 1024, F.G, bx); else S.init(NB * SEQ, 1024, F.G, bx, 1);
          pg8::EpiResid E{xl, xc, MOD + (size_t)L * 9 * 6 * 1024, 2}; pg8::gemm_phase<pg8::EpiResid, pg8::StaticOrder>(F.lds, g, S, E); }
        GRID_BAR();
        norm2_router_phase(F, a, L);
        GRID_BAR();
        topk_phase(F, a, L < 3 ? 256 : 128);
        GRID_BAR();
        { pg8::Gemm g{H, (const bf16_t*)(ws + WS_WGU), 1024, 1024, 1024, (const int*)(ws + WS_TOK)}; pg8::MoeOrder<8> S{F.G, F.vcu, L < 3 ? 33 : 32};
          pg8::EpiSwiGLU E{(bf16_t*)(ws + WS_GACT)}; pg8::gemm_phase<pg8::EpiSwiGLU, pg8::MoeOrder<8>, true>(F.lds, g, S, E); }
        GRID_BAR();
        { pg8::Gemm g{(const bf16_t*)(ws + WS_GACT), (const bf16_t*)(ws + WS_WD), 1024, 1024, 1024, nullptr}; pg8::MoeOrder<4> S{F.G, F.vcu, L < 3 ? 33 : 32};
          pg8::EpiBf16 E{(bf16_t*)(ws + WS_Y), (size_t)1024, 3}; pg8::gemm_phase<pg8::EpiBf16, pg8::MoeOrder<4>>(F.lds, g, S, E); }
        GRID_BAR();
    }
    norm1_phase(F, a, 4);
#undef a
#undef ws
#undef H
#undef xl
#undef xc
#undef MOD
}

extern "C" void kernel_launch(void* const* d_in, const int* in_sizes, int n_in, void* d_out, int out_size, void* d_ws, size_t ws_size, hipStream_t stream) {
    static int grid = 0;
    if (grid == 0) {
        if (n_in != 25 || in_sizes[0] != NB * SEQ * DM || out_size != NB * SEQ * DM || ws_size < WS_NEED) {
            fprintf(stderr, "kernel_launch: unexpected shapes (n_in %d, in0 %d, out %d, ws %zu < %zu); nothing launched\n", n_in, n_in > 0 ? in_sizes[0] : -1, out_size, ws_size, (size_t)WS_NEED); grid = -1; return; }
        int dev = 0, cus = 0;
        if (hipGetDevice(&dev) != hipSuccess || hipDeviceGetAttribute(&cus, hipDeviceAttributeMultiprocessorCount, dev) != hipSuccess) { grid = -1; return; }
        if (hipFuncSetAttribute((const void*)mega_fwd, hipFuncAttributeMaxDynamicSharedMemorySize, LDS_BYTES) != hipSuccess) { fprintf(stderr, "kernel_launch: hipFuncSetAttribute failed\n"); grid = -1; return; }
        (void)hipGetLastError();
        grid = cus;
    }
    if (grid < 0) return;
    if (hipMemsetAsync((char*)d_ws + WS_CTL, 0, CTL_BYTES, stream) != hipSuccess) return;
    Args a{};
    for (int i = 0; i < 25; ++i) a.in[i] = (const float GAS*)d_in[i];
    a.out = (float GAS*)d_out; a.ws = (unsigned char GAS*)d_ws;
    hipLaunchKernelGGL(mega_fwd, dim3(grid), dim3(NWAVES * 64), LDS_BYTES, stream, a);
}
```

```cpp
#include <hip/hip_runtime.h>
#include <cstdio>
#include <cstdint>

#define LAS __attribute__((address_space(3)))
#define GAS __attribute__((address_space(1)))
typedef unsigned short bf16_t;
typedef short bf16x8 __attribute__((ext_vector_type(8)));
typedef float f32x4 __attribute__((ext_vector_type(4)));
typedef float f32x2 __attribute__((ext_vector_type(2)));
typedef float f32x16 __attribute__((ext_vector_type(16)));
typedef unsigned u32x4 __attribute__((ext_vector_type(4)));
typedef unsigned u32x2 __attribute__((ext_vector_type(2)));
typedef __bf16 bf16x2_t __attribute__((ext_vector_type(2)));

constexpr int DM = 1024, NB = 8, SEQ = 8192, CTXL = 256, TPS = SEQ + CTXL, NR = NB * TPS;
constexpr int NEXP = 16, CAP_L = 1024, CAP_C = 32;
constexpr int NPAIR_L = NB * NEXP * CAP_L, NPAIR = NPAIR_L + NEXP * NB * CAP_C;
constexpr int QKW = 1792, VEW = 768, QW = 1536, CNW = 512;
constexpr float EPS = 1e-6f;
constexpr float LOG2E = 1.4426950408889634f;
constexpr float C2_EVEN = 0.125f * LOG2E;
constexpr float C2_ODD = 0.10206207261596577f * LOG2E;

constexpr size_t al(size_t x) { return (x + 255) & ~(size_t)255; }
constexpr size_t WS_CTL = 0, CTL_BYTES = 1u << 20;
constexpr size_t WS_MOD = WS_CTL + CTL_BYTES;
constexpr size_t WS_ROPE64 = WS_MOD + al((size_t)4 * 9 * 6 * 1024 * 4);
constexpr size_t WS_ROPE32 = WS_ROPE64 + al(128 * 16 * 2 * 4);
constexpr size_t WS_WP = WS_ROPE32 + al(128 * 8 * 2 * 4);
constexpr size_t WS_WQK = WS_WP + al((size_t)9 * 16384 * 4 + 9 * 16 * 4);
constexpr size_t WS_WVE = WS_WQK + al((size_t)2 * QKW * 1024 * 2);
constexpr size_t WS_WOE = WS_WVE + al((size_t)2 * VEW * 1024 * 2);
constexpr size_t WS_WINO = WS_WOE + al((size_t)2 * 1024 * 1024 * 2);
constexpr size_t WS_WQUP = WS_WINO + al((size_t)2 * 512 * 1024 * 2);
constexpr size_t WS_WKN = WS_WQUP + al((size_t)2 * 1536 * 256 * 2);
constexpr size_t WS_WVO = WS_WKN + al((size_t)2 * 1024 * 256 * 2);
constexpr size_t WS_WOO = WS_WVO + al((size_t)2 * 1024 * 256 * 2);
constexpr size_t WS_WGU = WS_WOO + al((size_t)2 * 1024 * 1024 * 2);
constexpr size_t WS_WD = WS_WGU + al((size_t)16 * 2048 * 1024 * 2);
constexpr size_t WS_XCTX = WS_WD + al((size_t)16 * 1024 * 1024 * 2);
constexpr size_t WS_H = WS_XCTX + al((size_t)NB * CTXL * 1024 * 4);
constexpr size_t WS_AFF = WS_H + al((size_t)NR * 1024 * 2);
constexpr size_t WS_SLOT = WS_AFF + al((size_t)NR * 16 * 4);
constexpr size_t WS_TOK = WS_SLOT + al((size_t)NR * 16 * 4);
constexpr size_t WS_BIG = WS_TOK + al((size_t)NPAIR * 4);
constexpr size_t WS_QK = WS_BIG;
constexpr size_t WS_VTE = WS_QK + al((size_t)NR * QKW * 2);
constexpr size_t WS_OB = WS_VTE + al((size_t)VEW * NR * 2);
constexpr size_t WS_END_E = WS_OB + al((size_t)NR * 1024 * 2);
constexpr size_t WS_CRAW = WS_BIG;
constexpr size_t WS_CN = WS_CRAW + al((size_t)NR * 512 * 4);
constexpr size_t WS_KR = WS_CN + al((size_t)NR * CNW * 2);
constexpr size_t WS_Q = WS_KR + al((size_t)NR * 32 * 2);
constexpr size_t WS_KN = WS_Q + al((size_t)NR * QW * 2);
constexpr size_t WS_VTO = WS_KN + al((size_t)NR * 1024 * 2);
constexpr size_t WS_END_O = WS_VTO + al((size_t)1024 * NR * 2);
constexpr size_t WS_GACT = WS_BIG;
constexpr size_t WS_Y = WS_GACT + al((size_t)NPAIR * 1024 * 2);
constexpr size_t WS_END_M = WS_Y + al((size_t)NPAIR * 1024 * 2);
constexpr size_t WS_NEED = (WS_END_O > WS_END_E ? (WS_END_O > WS_END_M ? WS_END_O : WS_END_M) : (WS_END_E > WS_END_M ? WS_END_E : WS_END_M));

constexpr int RING_BYTES = 131072;
constexpr int LDSCTL_OFF = RING_BYTES, MISC_OFF = LDSCTL_OFF + 320;
constexpr int LDS_BYTES = 147456;
constexpr int NWAVES = 8;

__device__ __forceinline__ unsigned cvtpk(float lo, float hi) { f32x2 v = {lo, hi}; bf16x2_t b = __builtin_convertvector(v, bf16x2_t); return __builtin_bit_cast(unsigned, b); }
__device__ __forceinline__ float bf_lo(unsigned w) { return __uint_as_float(w << 16); }
__device__ __forceinline__ float bf_hi(unsigned w) { return __uint_as_float(w & 0xffff0000u); }
__device__ __forceinline__ float wave_sum(float v) {
#pragma unroll
    for (int o = 1; o < 64; o <<= 1) v += __shfl_xor(v, o);
    return v;
}
#define LDS_WAIT() asm volatile("s_waitcnt lgkmcnt(0)" ::: "memory")
#define VM_WAIT() asm volatile("s_waitcnt vmcnt(0)" ::: "memory")

namespace pg8 {
constexpr int BM = 256, BK = 64, HALF = 128, HTB = HALF * BK * 2, STAGE_BYTES = 8 * HTB, NXCD = 8, WGM = 8;
__host__ __device__ __forceinline__ int lds_byte(int r, int c) { const int st = (r >> 4) * 2 + (c >> 5), rr = r & 15, cc = c & 31, ob = rr * 64 + cc * 2; return st * 1024 + (ob ^ (((ob >> 9) & 1) << 5)); }
__host__ __device__ __forceinline__ void stage_rc(int b, int& R, int& C) { const int st = b / 1024, sb = b % 1024, swz = sb ^ (((sb >> 9) & 1) << 5); R = (st >> 1) * 16 + swz / 64; C = (st & 1) * 32 + (swz % 64) / 2; }
__host__ __device__ __forceinline__ int perm32(int rho) { const int n = rho >> 4, i = rho & 15; return 8 * (i >> 2) + 4 * n + (i & 3); }

struct Unit { int pm, pn; };
struct Gemm { const bf16_t* A; const bf16_t* Bt; int lda, ldb, K; const int* gidx; };

struct StaticOrder {
    int nM, nN, nwg, G, c, lat;
    __device__ void init(int M, int N, int G_, int c_, int lat_ = 0) { nM = M / BM; nN = N / BM; nwg = nM * nN; G = G_; c = c_; lat = lat_; }
    __device__ bool next(int i, Unit& u) const {
        const long L = (long)i * G + c; if (L >= nwg) return false;
        int wgid = (int)L; { const int q = nwg / NXCD, r = nwg % NXCD, xcd = wgid % NXCD, off = wgid / NXCD; wgid = (xcd < r ? xcd * (q + 1) : r * (q + 1) + (xcd - r) * q) + off; }
        const int nig = WGM * nN, gid = wgid / nig, fm = gid * WGM, gsz = (nM - fm) < WGM ? (nM - fm) : WGM;
        u.pm = fm + ((wgid % nig) % gsz); u.pn = (wgid % nig) / gsz; if (lat) u.pm = (u.pm >> 5) * 33 + (u.pm & 31); return true;
    }
};
template <int NJ> struct MoeOrder {
    int G, c, nrt;
    __device__ bool next(int i, Unit& u) const {
        const int L = i * G + c; if (L >= 16 * nrt * NJ) return false;
        const int e = L / (nrt * NJ), rem = L - e * (nrt * NJ), rt = rem / NJ, j = rem - rt * NJ;
        u.pm = (rt < 32) ? (((rt >> 2) * 16 + e) * 4 + (rt & 3)) : (512 + e);
        u.pn = e * NJ + j; return true;
    }
};

struct EpiBf16 {
    static constexpr bool PERM = true;
    bf16_t* O; size_t ldc; int pnmask;
    __device__ __forceinline__ void operator()(const f32x4 (&acc)[2][2][4][2], const Unit& u, int wr, int wc, int fr, int fq) const {
        const int row0 = u.pm * BM + wr * 64 + fr; const int col0 = (u.pn & pnmask) * BM + wc * 32 + 8 * fq;
#pragma unroll
        for (int ai = 0; ai < 2; ++ai)
#pragma unroll
            for (int m = 0; m < 4; ++m) { bf16_t* rowp = O + (size_t)(row0 + ai * HALF + m * 16) * ldc + col0;
#pragma unroll
                for (int bj = 0; bj < 2; ++bj) { const f32x4 v0 = acc[ai][bj][m][0], v1 = acc[ai][bj][m][1];
                    u32x4 w; w.x = cvtpk(v0[0], v0[1]); w.y = cvtpk(v0[2], v0[3]); w.z = cvtpk(v1[0], v1[1]); w.w = cvtpk(v1[2], v1[3]);
                    *(u32x4*)(rowp + bj * HALF) = w; } }
    }
};
struct EpiF32 {
    static constexpr bool PERM = false;
    float* O; size_t ldc;
    __device__ __forceinline__ void operator()(const f32x4 (&acc)[2][2][4][2], const Unit& u, int wr, int wc, int fr, int fq) const {
        const int row0 = u.pm * BM + wr * 64 + fr; const int col0 = u.pn * BM + wc * 32 + 4 * fq;
#pragma unroll
        for (int ai = 0; ai < 2; ++ai)
#pragma unroll
            for (int m = 0; m < 4; ++m) { float* rowp = O + (size_t)(row0 + ai * HALF + m * 16) * ldc + col0;
#pragma unroll
                for (int bj = 0; bj < 2; ++bj)
#pragma unroll
                    for (int n = 0; n < 2; ++n) *(f32x4*)(rowp + bj * HALF + n * 16) = acc[ai][bj][m][n]; }
    }
};
struct EpiResid {
    static constexpr bool PERM = false;
    float* xl; float* xc; const float* mod; int gk;
    __device__ __forceinline__ void operator()(const f32x4 (&acc)[2][2][4][2], const Unit& u, int wr, int wc, int fr, int fq) const {
        const int b = u.pm / 33, j = u.pm - b * 33;
        float* base = (j < 32) ? xl + ((size_t)(b * SEQ + j * 256)) * DM : xc + ((size_t)(b * CTXL)) * DM;
        const float* gv = mod + ((j < 32 ? b : 8) * 6 + gk) * 1024;
        const int rl0 = wr * 64 + fr; const int col0 = u.pn * BM + wc * 32 + 4 * fq;
        f32x4 g[2][2];
#pragma unroll
        for (int bj = 0; bj < 2; ++bj)
#pragma unroll
            for (int n = 0; n < 2; ++n) g[bj][n] = *(const f32x4*)(gv + col0 + bj * HALF + n * 16);
#pragma unroll
        for (int ai = 0; ai < 2; ++ai)
#pragma unroll
            for (int m = 0; m < 4; ++m) { float* rowp = base + (size_t)(rl0 + ai * HALF + m * 16) * DM + col0;
#pragma unroll
                for (int bj = 0; bj < 2; ++bj)
#pragma unroll
                    for (int n = 0; n < 2; ++n) { f32x4* p = (f32x4*)(rowp + bj * HALF + n * 16); const f32x4 xv = *p; *p = xv + g[bj][n] * acc[ai][bj][m][n]; }
                asm volatile("" ::: "memory"); }
    }
};
struct EpiSwiGLU {
    static constexpr bool PERM = true;
    bf16_t* O;
    __device__ __forceinline__ void operator()(const f32x4 (&acc)[2][2][4][2], const Unit& u, int wr, int wc, int fr, int fq) const {
        const int row0 = u.pm * BM + wr * 64 + fr; const int col0 = (u.pn & 7) * HALF + wc * 32 + 8 * fq;
#pragma unroll
        for (int ai = 0; ai < 2; ++ai)
#pragma unroll
            for (int m = 0; m < 4; ++m) { bf16_t* rowp = O + (size_t)(row0 + ai * HALF + m * 16) * DM + col0;
                float r[8];
#pragma unroll
                for (int n = 0; n < 2; ++n)
#pragma unroll
                    for (int k = 0; k < 4; ++k) { const float a = acc[ai][0][m][n][k], up = acc[ai][1][m][n][k];
                        r[n * 4 + k] = a * __builtin_amdgcn_rcpf(1.f + __builtin_amdgcn_exp2f(-a * LOG2E)) * up; }
                u32x4 w; w.x = cvtpk(r[0], r[1]); w.y = cvtpk(r[2], r[3]); w.z = cvtpk(r[4], r[5]); w.w = cvtpk(r[6], r[7]);
                *(u32x4*)rowp = w; }
    }
};

template <class Epi, class Sched, bool GATHER = false>
__device__ __forceinline__ void gemm_phase(LAS unsigned char* lds, const Gemm g, const Sched& S, const Epi& E) {
    int tid_ = threadIdx.x; asm volatile("" : "+v"(tid_));
    const int tid = tid_, wid = __builtin_amdgcn_readfirstlane(tid >> 6), lane = tid & 63, wr = wid >> 2, wc = wid & 3, fr = lane & 15, fq = lane >> 4;
    const int K = g.K, nt = K / BK;
    int RA[2], CA[2]; unsigned voffB[2];
#pragma unroll
    for (int i = 0; i < 2; ++i) { int R, C; stage_rc(tid * 16 + i * 8192, R, C); const int Rb = Epi::PERM ? ((R & ~31) + perm32(R & 31)) : R;
        RA[i] = R; CA[i] = C; voffB[i] = (unsigned)(Rb * g.ldb + C) * 2u; }
    const size_t kstep = (size_t)(BK * 2);
    const size_t hstepB = (size_t)HALF * g.ldb * 2, tstepB = 2 * hstepB, hstepA = (size_t)HALF * g.lda * 2, tstepA = 2 * hstepA;
    unsigned voA[2];
#pragma unroll
    for (int i = 0; i < 2; ++i) voA[i] = (unsigned)(RA[i] * g.lda + CA[i]) * 2u;
    const unsigned ldsw = (unsigned)wid * 1024u;
    const int aoff = lds_byte(wr * 64 + fr, fq * 8), boff = lds_byte(wc * 32 + fr, fq * 8);
    unsigned voC[2][2], voN[2][2];
#define PG8_SA(b, h) (((b) * 2 + (h)) * HTB)
#define PG8_SB(b, h) ((4 + (b) * 2 + (h)) * HTB)
#define PG8_STAGE_B(bufoff, gbase) do { _Pragma("unroll") for (int _i = 0; _i < 2; ++_i) \
        __builtin_amdgcn_global_load_lds((const unsigned*)((const char*)(gbase) + voffB[_i]), (LAS unsigned*)(lds + (bufoff) + ldsw + _i * 8192), 16, 0, 0); } while (0)
#define PG8_STAGE_A(bufoff, gbase, vo, h) do { _Pragma("unroll") for (int _i = 0; _i < 2; ++_i) { \
        if constexpr (GATHER) __builtin_amdgcn_global_load_lds((const unsigned*)((const char*)(gbase) + (vo)[h][_i]), (LAS unsigned*)(lds + (bufoff) + ldsw + _i * 8192), 16, 0, 0); \
        else __builtin_amdgcn_global_load_lds((const unsigned*)((const char*)(gbase) + (h) * hstepA + voA[_i]), (LAS unsigned*)(lds + (bufoff) + ldsw + _i * 8192), 16, 0, 0); } } while (0)
#define PG8_LDA(dst, b, h) do { _Pragma("unroll") for (int m = 0; m < 4; ++m) _Pragma("unroll") for (int k = 0; k < 2; ++k) dst[m][k] = *(const LAS bf16x8*)(lds + PG8_SA(b, h) + aoff + m * 2048 + k * 1024); } while (0)
#define PG8_LDB(dst, b, h) do { _Pragma("unroll") for (int n = 0; n < 2; ++n) _Pragma("unroll") for (int k = 0; k < 2; ++k) dst[n][k] = *(const LAS bf16x8*)(lds + PG8_SB(b, h) + boff + n * 2048 + k * 1024); } while (0)
#define PG8_MMA(ai, bj, At, Bt) do { __builtin_amdgcn_s_setprio(1); _Pragma("unroll") for (int m = 0; m < 4; ++m) _Pragma("unroll") for (int n = 0; n < 2; ++n) _Pragma("unroll") for (int k = 0; k < 2; ++k) \
        acc[ai][bj][m][n] = __builtin_amdgcn_mfma_f32_16x16x32_bf16(Bt[n][k], At[m][k], acc[ai][bj][m][n], 0, 0, 0); __builtin_amdgcn_s_setprio(0); } while (0)
#define PG8_WAIT_V(n) asm volatile("s_waitcnt vmcnt(" #n ")" ::: "memory")
#define PG8_WAIT_L(n) asm volatile("s_waitcnt lgkmcnt(" #n ")" ::: "memory")
#define PG8_BAR __builtin_amdgcn_s_barrier()
#define PG8_SCHED __builtin_amdgcn_sched_barrier(0)
#define PG8_VOFFS(vo, unit) do { if constexpr (GATHER) { _Pragma("unroll") for (int _h = 0; _h < 2; ++_h) _Pragma("unroll") for (int _i = 0; _i < 2; ++_i) \
        (vo)[_h][_i] = (unsigned)(g.gidx[(unit).pm * BM + _h * HALF + RA[_i]] * g.lda + CA[_i]) * 2u; } } while (0)
    Unit cur, nxt; int ui = 0;
    if (!S.next(0, cur)) return;
    f32x4 acc[2][2][4][2];
#pragma unroll
    for (int a = 0; a < 2; ++a)
#pragma unroll
        for (int b = 0; b < 2; ++b)
#pragma unroll
            for (int m = 0; m < 4; ++m)
#pragma unroll
                for (int n = 0; n < 2; ++n) acc[a][b][m][n] = (f32x4){0.f, 0.f, 0.f, 0.f};
    bf16x8 At[4][2], B0[2][2], B1[2][2];
    PG8_VOFFS(voC, cur);
    const char* cA = GATHER ? (const char*)g.A : (const char*)g.A + (size_t)cur.pm * tstepA; const char* cB = (const char*)g.Bt + (size_t)cur.pn * tstepB;
    PG8_STAGE_B(PG8_SB(0, 0), cB); PG8_STAGE_B(PG8_SB(0, 1), cB + hstepB); PG8_STAGE_A(PG8_SA(0, 0), cA, voC, 0); PG8_STAGE_A(PG8_SA(0, 1), cA, voC, 1);
    if (wr == 1) PG8_BAR;
    PG8_WAIT_V(2); PG8_BAR;
    PG8_STAGE_B(PG8_SB(1, 0), cB + kstep); PG8_STAGE_A(PG8_SA(1, 0), cA + kstep, voC, 0); PG8_STAGE_B(PG8_SB(1, 1), cB + hstepB + kstep);
    PG8_WAIT_V(6); PG8_BAR;
    for (;;) {
        const bool has_next = S.next(ui + 1, nxt);
        if constexpr (GATHER) { if (has_next) { PG8_VOFFS(voN, nxt); } else {
#pragma unroll
            for (int _h = 0; _h < 2; ++_h)
#pragma unroll
                for (int _i = 0; _i < 2; ++_i) voN[_h][_i] = voC[_h][_i]; } }
        const char* nA = GATHER ? (const char*)g.A : (has_next ? (const char*)g.A + (size_t)nxt.pm * tstepA : cA);
        const char* nB = has_next ? (const char*)g.Bt + (size_t)nxt.pn * tstepB : cB;
        for (int t = 0; t < nt; t += 2) {
            const bool last = (t == nt - 2);
            const char* a1 = cA + (size_t)(t + 1) * kstep;
            const char* a2 = last ? nA : cA + (size_t)(t + 2) * kstep; const char* b2 = last ? nB : cB + (size_t)(t + 2) * kstep;
            const char* a3 = a2 + kstep; const char* b3 = b2 + kstep;
            unsigned vo2[2][2];
            if constexpr (GATHER) {
#pragma unroll
            for (int _h = 0; _h < 2; ++_h)
#pragma unroll
                for (int _i = 0; _i < 2; ++_i) vo2[_h][_i] = last ? voN[_h][_i] : voC[_h][_i]; }
            PG8_LDB(B0, 0, 0); PG8_LDB(B1, 0, 1); PG8_SCHED; PG8_LDA(At, 0, 0); PG8_STAGE_A(PG8_SA(1, 1), a1, voC, 1);
            PG8_WAIT_V(8); PG8_WAIT_L(0); PG8_BAR; PG8_MMA(0, 0, At, B0); PG8_MMA(0, 1, At, B1); PG8_BAR; PG8_SCHED;
            PG8_LDA(At, 0, 1); PG8_STAGE_B(PG8_SB(0, 0), b2); PG8_STAGE_B(PG8_SB(0, 1), b2 + hstepB); PG8_STAGE_A(PG8_SA(0, 0), a2, vo2, 0);
            PG8_WAIT_V(8); PG8_WAIT_L(0); PG8_BAR; PG8_MMA(1, 0, At, B0); PG8_MMA(1, 1, At, B1); PG8_BAR; PG8_SCHED;
            PG8_LDB(B0, 1, 0); PG8_LDB(B1, 1, 1); PG8_SCHED; PG8_LDA(At, 1, 0); PG8_STAGE_A(PG8_SA(0, 1), a2, vo2, 1);
            PG8_WAIT_V(8); PG8_WAIT_L(0); PG8_BAR; PG8_MMA(0, 0, At, B0); PG8_MMA(0, 1, At, B1); PG8_BAR; PG8_SCHED;
            PG8_LDA(At, 1, 1); PG8_STAGE_B(PG8_SB(1, 0), b3); PG8_STAGE_B(PG8_SB(1, 1), b3 + hstepB); PG8_STAGE_A(PG8_SA(1, 0), a3, vo2, 0);
            PG8_WAIT_V(8); PG8_WAIT_L(0); PG8_BAR; PG8_MMA(1, 0, At, B0); PG8_MMA(1, 1, At, B1); PG8_BAR; PG8_SCHED;
        }
        if (wr == 0) PG8_BAR;
        E(acc, cur, wr, wc, fr, fq);
        if (!has_next) break;
#pragma unroll
        for (int a = 0; a < 2; ++a)
#pragma unroll
            for (int b = 0; b < 2; ++b)
#pragma unroll
                for (int m = 0; m < 4; ++m)
#pragma unroll
                    for (int n = 0; n < 2; ++n) acc[a][b][m][n] = (f32x4){0.f, 0.f, 0.f, 0.f};
        cur = nxt; cA = nA; cB = nB; ++ui;
        if constexpr (GATHER) {
#pragma unroll
        for (int _h = 0; _h < 2; ++_h)
#pragma unroll
            for (int _i = 0; _i < 2; ++_i) voC[_h][_i] = voN[_h][_i]; }
        if (wr == 1) PG8_BAR;
    }
    PG8_WAIT_V(0);
    PG8_BAR;
#undef PG8_SA
#undef PG8_SB
#undef PG8_STAGE_A
#undef PG8_STAGE_B
#undef PG8_LDA
#undef PG8_LDB
#undef PG8_MMA
#undef PG8_WAIT_V
#undef PG8_WAIT_L
#undef PG8_BAR
#undef PG8_SCHED
#undef PG8_VOFFS
}
}

typedef GAS unsigned gu32;
#define RLX_AGENT __ATOMIC_RELAXED, __HIP_MEMORY_SCOPE_AGENT
#define XB_TMO      128
#define XB_XCNT(j)  (256  + 64 * (j))
#define XB_XSUB(j)  (1280 + 64 * (j))
#define XB_XGEN(j)  (2304 + 64 * (j))
#define XB_TOP      3328
#define XB_TOPGEN   3392
#define XCD_BAR_WORDS 3456
#define XB_SPIN_CAP (1u << 22)
__device__ __forceinline__ unsigned xb_ld(unsigned* p)              { return __hip_atomic_load(p, __ATOMIC_RELAXED, __HIP_MEMORY_SCOPE_AGENT); }
__device__ __forceinline__ unsigned xb_add(unsigned* p, unsigned v) { return __hip_atomic_fetch_add(p, v, __ATOMIC_RELAXED, __HIP_MEMORY_SCOPE_AGENT); }
__device__ __forceinline__ unsigned xb_xcc_id() { return (unsigned)__builtin_amdgcn_s_getreg((3 << 11) | 20) & 0xFu; }
#define XB_SPIN(cond, bar) do { unsigned _sp = 0; while (cond) { __builtin_amdgcn_s_sleep(1); \
    if ((++_sp & 255u) == 0u) { if (xb_ld(&(bar)[XB_TMO])) break; if (_sp > XB_SPIN_CAP) { atomicAdd(&(bar)[XB_TMO], 1u); break; } } } } while (0)
struct XcdBarrier { unsigned* bar; unsigned x; volatile LAS unsigned* st; };
__device__ __forceinline__ XcdBarrier xcd_barrier_post(unsigned* bar, volatile LAS unsigned* st) {
    XcdBarrier b; b.bar = bar; b.x = xb_xcc_id(); b.st = st;
    if (threadIdx.x == 0) (void)xb_add(&bar[XB_XCNT(b.x)], 1u);
    return b;
}
__device__ __forceinline__ void xcd_barrier_complete(unsigned* bar, unsigned x, unsigned& nloc, unsigned& nx) {
    const unsigned G = gridDim.x * gridDim.y * gridDim.z;
    unsigned sum, cnt, mine, sp = 0u;
    for (;;) {
        sum = 0u; cnt = 0u; mine = 0u;
#pragma unroll
        for (unsigned j = 0; j < 16; ++j) { const unsigned c = xb_ld(&bar[XB_XCNT(j)]); sum += c; cnt += (c > 0u) ? 1u : 0u; mine = (j == x) ? c : mine; }
        if (sum == G) break;
        __builtin_amdgcn_s_sleep(1);
        if ((++sp & 255u) == 0u) { if (xb_ld(&bar[XB_TMO])) break; if (sp > XB_SPIN_CAP) { atomicAdd(&bar[XB_TMO], 1u); break; } }
    }
    nloc = mine > 0u ? mine : 1u; nx = cnt > 0u ? cnt : 1u;
}
__device__ __forceinline__ void xcd_barrier(const XcdBarrier& b) {
    asm volatile("s_waitcnt vmcnt(0)" ::: "memory");
    __syncthreads();
    if (threadIdx.x == 0) {
        unsigned* bar = b.bar;
        __builtin_amdgcn_s_waitcnt(0);
        unsigned nloc = b.st[0], nx = b.st[1];
        if (nloc == 0u) { xcd_barrier_complete(bar, b.x, nloc, nx); b.st[0] = nloc; b.st[1] = nx; }
        const unsigned old = xb_add(&bar[XB_XSUB(b.x)], 1u);
        const unsigned gen = old / nloc;
        if (old + 1u == (gen + 1u) * nloc) {
            __builtin_amdgcn_fence(__ATOMIC_RELEASE, "agent");
            asm volatile("s_waitcnt vmcnt(0)" ::: "memory");
            const unsigned og = xb_add(&bar[XB_TOP], 1u);
            const unsigned tg = og / nx;
            if (og + 1u == (tg + 1u) * nx) xb_add(&bar[XB_TOPGEN], 1u);
            else XB_SPIN(xb_ld(&bar[XB_TOPGEN]) == tg, bar);
            __builtin_amdgcn_fence(__ATOMIC_ACQUIRE, "agent");
            xb_add(&bar[XB_XGEN(b.x)], 1u);
            asm volatile("s_waitcnt vmcnt(0)" ::: "memory");
        } else {
            XB_SPIN(xb_ld(&bar[XB_XGEN(b.x)]) == gen, bar);
            __builtin_amdgcn_fence(__ATOMIC_ACQUIRE, "agent");
            asm volatile("s_waitcnt vmcnt(0)" ::: "memory");
        }
    }
    __syncthreads();
}

namespace att {
__device__ __forceinline__ void glds16(const void* gsrc, unsigned lds_dst) { unsigned keep;
    asm volatile("s_mov_b32 %0, m0\n\ts_mov_b32 m0, %2\n\ts_nop 0\n\tglobal_load_lds_dwordx4 %1, off\n\ts_mov_b32 m0, %0" : "=&s"(keep) : "v"(gsrc), "s"(lds_dst) : "memory"); }
template <int N> __device__ __forceinline__ void wait_bar() {
    static_assert(N >= 0 && N <= 3, "wait_bar");
    if constexpr (N == 0) asm volatile("s_waitcnt vmcnt(0) lgkmcnt(0)\n\ts_barrier" ::: "memory");
    else if constexpr (N == 1) asm volatile("s_waitcnt vmcnt(1) lgkmcnt(0)\n\ts_barrier" ::: "memory");
    else if constexpr (N == 2) asm volatile("s_waitcnt vmcnt(2) lgkmcnt(0)\n\ts_barrier" ::: "memory");
    else asm volatile("s_waitcnt vmcnt(3) lgkmcnt(0)\n\ts_barrier" ::: "memory");
}
__device__ __forceinline__ float lanes4_sum(float v) {
    { auto rr = __builtin_amdgcn_permlane16_swap(__float_as_uint(v), __float_as_uint(v), false, false); v = __uint_as_float(rr[0]) + __uint_as_float(rr[1]); }
    { auto rr = __builtin_amdgcn_permlane32_swap(__float_as_uint(v), __float_as_uint(v), false, false); v = __uint_as_float(rr[0]) + __uint_as_float(rr[1]); }
    return v; }
constexpr int NSLOT = 3, KOFF = 0, VOFF = NSLOT * 12288, ATT_LDS = VOFF + NSLOT * 16384;
static_assert(ATT_LDS + 8 * 4096 <= RING_BYTES, "attention LDS (rings + per-wave O stage)");
#define ATT_SB() __builtin_amdgcn_sched_barrier(0)
template <int DQK, int DV, bool LEAD>
__device__ __forceinline__ void attn_unit_impl(const bf16_t* Q, int qpitch, const bf16_t* K, int kpitch, const bf16_t* KR, const bf16_t* Vt, bf16_t* O, int opitch,
                                          int qrow0, int krow0, int NT, LAS unsigned char* shm, const float* qgain, const f32x2* rope, int tq0) {
    static_assert((DQK == 64 || DQK == 96) && (DV == 64 || DV == 128), "shapes");
    constexpr int KSLOT = DQK * 128, VSLOT = DV * 128, NKD = (DQK == 96 ? 2 : 1), NVD = DV / 64, NDMA = NKD + NVD, NDS = DQK / 32, NDB = DV / 16;
    constexpr bool KS = (DV == 64); constexpr int NQB = KS ? 4 : 2, NKW = KS ? 2 : 4, NSW = KS ? 1 : 2, NVF = KS ? 4 : 8;
    static_assert(NDMA == 2 || NDMA == 3, "dma count");
    int tid_ = threadIdx.x; asm volatile("" : "+v"(tid_));
    const int tid = tid_, lane = tid & 63, q16 = lane & 15, g4 = lane >> 4, hi = lane >> 5; const int wid = __builtin_amdgcn_readfirstlane(tid >> 6);
    const int kg = KS ? (wid >> 2) : 0, qoff = KS ? (wid & 3) * 64 : wid * 32;
    const unsigned lds0 = (unsigned)(uintptr_t)shm;
    const int krow_l = wid * 8 + (lane >> 3);
    const int kc_l = (lane & 7) ^ (((krow_l >> 1) & 1) | (((krow_l >> 3) & 1) << 1) | (((krow_l >> 4) & 1) << 2));
    const int vc_l = (lane & 7) ^ ((krow_l >> 1) & 7);
    const bf16_t* ksrc = K + (size_t)(krow0 + krow_l) * kpitch + kc_l * 8;
    const int rrow_l = (wid & 3) * 16 + (lane >> 2), rc_l = (lane & 3) ^ (((rrow_l >> 4) & 1) << 1);
    const bf16_t* krsrc = (DQK == 96) ? KR + (size_t)(krow0 + rrow_l) * 32 + rc_l * 8 : nullptr;
    const bf16_t* vsrc = Vt + (size_t)krow_l * NR + krow0 + vc_l * 8;
    const unsigned kdst = lds0 + KOFF + wid * 1024, krdst = lds0 + KOFF + 8192 + (wid & 3) * 1024, vdst = lds0 + VOFF + wid * 1024;
#define ATT_DMA_K(t, sl) do { glds16(ksrc + (size_t)(t) * 64 * kpitch, (unsigned)__builtin_amdgcn_readfirstlane(kdst + (sl) * KSLOT)); \
        if constexpr (DQK == 96) glds16(krsrc + (size_t)(t) * 64 * 32, (unsigned)__builtin_amdgcn_readfirstlane(krdst + (sl) * KSLOT)); } while (0)
#define ATT_DMA_V(t, sl) do { glds16(vsrc + (size_t)(t) * 64, (unsigned)__builtin_amdgcn_readfirstlane(vdst + (sl) * VSLOT)); \
        if constexpr (DV == 128) glds16(vsrc + (size_t)64 * NR + (size_t)(t) * 64, (unsigned)__builtin_amdgcn_readfirstlane(vdst + (sl) * VSLOT + 8192)); } while (0)
    const int kr0 = 8 * (q16 >> 2) + (q16 & 3);
    const int fk = ((kr0 >> 1) & 1) | (((kr0 >> 3) & 1) << 1) | (((kr0 >> 4) & 1) << 2);
    const LAS unsigned char* kp[2]; const LAS unsigned char* vp[2];
#pragma unroll
    for (int ds = 0; ds < 2; ++ds) kp[ds] = shm + KOFF + kr0 * 128 + ((((ds << 2) | g4) ^ fk) << 4) + kg * 4096;
    const LAS unsigned char* krp = shm + KOFF + 8192 + kr0 * 64 + ((g4 ^ (((kr0 >> 4) & 1) << 1)) << 4) + kg * 2048;
#pragma unroll
    for (int s_ = 0; s_ < 2; ++s_) vp[s_] = shm + VOFF + q16 * 128 + ((((s_ << 2) | g4) ^ ((q16 >> 1) & 7)) << 4);
    const LAS unsigned char* vpk = kg ? vp[1] : vp[0];
#define ATT_KLOAD(sl) do { _Pragma("unroll") for (int kb_ = 0; kb_ < NKW; ++kb_) _Pragma("unroll") for (int ds_ = 0; ds_ < NDS; ++ds_) { \
        if (ds_ < 2) kf[kb_ * NDS + ds_] = *(const LAS bf16x8*)(kp[ds_ & 1] + (sl) * KSLOT + (kb_ & 1) * 512 + (kb_ >> 1) * 4096); \
        else kf[kb_ * NDS + ds_] = *(const LAS bf16x8*)(krp + (sl) * KSLOT + (kb_ & 1) * 256 + (kb_ >> 1) * 2048); } } while (0)
#define ATT_QK() do { _Pragma("unroll") for (int kb_ = 0; kb_ < NKW; ++kb_) _Pragma("unroll") for (int ds_ = 0; ds_ < NDS; ++ds_) _Pragma("unroll") for (int qb_ = 0; qb_ < NQB; ++qb_) \
        c[kb_][qb_] = __builtin_amdgcn_mfma_f32_16x16x32_bf16(kf[kb_ * NDS + ds_], qf[qb_ * NDS + ds_], ds_ == 0 ? zero4 : c[kb_][qb_], 0, 0, 0); } while (0)
#define ATT_VLOAD(sl, h_) do { _Pragma("unroll") for (int g_ = 0; g_ < NVF; ++g_) { \
        if constexpr (KS) vf[g_] = *(const LAS bf16x8*)(vpk + (sl) * VSLOT + g_ * 2048); \
        else vf[g_] = *(const LAS bf16x8*)(vp[g_ & 1] + (sl) * VSLOT + ((h_) * 4 + (g_ >> 1)) * 2048); } } while (0)
#define ATT_PVP(h_) do { _Pragma("unroll") for (int g_ = 0; g_ < NVF; ++g_) _Pragma("unroll") for (int qb_ = 0; qb_ < NQB; ++qb_) { \
        const int db_ = KS ? g_ : (h_) * 4 + (g_ >> 1), sq_ = KS ? 0 : (g_ & 1); \
        o[db_][qb_] = __builtin_amdgcn_mfma_f32_16x16x32_bf16(vf[g_], __builtin_bit_cast(bf16x8, pw[sq_ * NQB + qb_]), o[db_][qb_], 0, 0, 0); } } while (0)
#define ATT_EXP() do { _Pragma("unroll") for (int kb_ = 0; kb_ < NKW; ++kb_) _Pragma("unroll") for (int qb_ = 0; qb_ < NQB; ++qb_) _Pragma("unroll") for (int i_ = 0; i_ < 4; ++i_) \
        c[kb_][qb_][i_] = __builtin_amdgcn_exp2f(c[kb_][qb_][i_]); } while (0)
#define ATT_SUMPACK() do { float pa_[NQB]; _Pragma("unroll") for (int qb_ = 0; qb_ < NQB; ++qb_) pa_[qb_] = (c[0][qb_][0] + c[0][qb_][1]) + (c[0][qb_][2] + c[0][qb_][3]); \
        _Pragma("unroll") for (int kb_ = 1; kb_ < NKW; ++kb_) _Pragma("unroll") for (int i_ = 0; i_ < 4; ++i_) { _Pragma("unroll") for (int qb_ = 0; qb_ < NQB; ++qb_) pa_[qb_] += c[kb_][qb_][i_]; \
            if constexpr (NQB == 2) asm volatile("" : "+v"(pa_[0]), "+v"(pa_[1])); else asm volatile("" : "+v"(pa_[0]), "+v"(pa_[1]), "+v"(pa_[2]), "+v"(pa_[3])); } \
        _Pragma("unroll") for (int qb_ = 0; qb_ < NQB; ++qb_) lsum[qb_] += pa_[qb_];     \
        _Pragma("unroll") for (int s_ = 0; s_ < NSW; ++s_) _Pragma("unroll") for (int qb_ = 0; qb_ < NQB; ++qb_) { \
            pw[s_ * NQB + qb_][0] = cvtpk(c[2 * s_][qb_][0], c[2 * s_][qb_][1]); pw[s_ * NQB + qb_][1] = cvtpk(c[2 * s_][qb_][2], c[2 * s_][qb_][3]); \
            pw[s_ * NQB + qb_][2] = cvtpk(c[2 * s_ + 1][qb_][0], c[2 * s_ + 1][qb_][1]); pw[s_ * NQB + qb_][3] = cvtpk(c[2 * s_ + 1][qb_][2], c[2 * s_ + 1][qb_][3]); } } while (0)
    ATT_DMA_K(0, 0); ATT_DMA_V(0, 0); ATT_DMA_K(1, 1); ATT_DMA_K(2, 2);
    bf16x8 qf[NQB * NDS];
    {
      const float c2 = (DQK == 64) ? C2_EVEN : C2_ODD; const bool lat = tq0 >= 0;
#pragma unroll
      for (int qb = 0; qb < NQB; ++qb) {
          const bf16_t* qp = Q + (size_t)(qrow0 + qoff + qb * 16 + q16) * qpitch + g4 * 8;
          bf16x8 raw[NDS];
#pragma unroll
          for (int ds = 0; ds < NDS; ++ds) raw[ds] = *(const bf16x8*)(qp + ds * 32);
          float x[NDS][8];
#pragma unroll
          for (int ds = 0; ds < NDS; ++ds)
#pragma unroll
              for (int j = 0; j < 8; ++j) x[ds][j] = __uint_as_float(((unsigned)(unsigned short)raw[ds][j]) << 16);
          const int tq = tq0 + qoff + qb * 16 + q16, prow = (tq >> 6) & 127, pcol = tq & 63;
          float sn = 0.f;
#pragma unroll
          for (int ds = 0; ds < 2; ++ds)
#pragma unroll
              for (int j = 0; j < 8; ++j) sn += x[ds][j] * x[ds][j];
          sn = lanes4_sum(sn);
          const float rn = rsqrtf(sn * (1.f / 64.f) + EPS);
#pragma unroll
          for (int ds = 0; ds < 2; ++ds)
#pragma unroll
              for (int j = 0; j < 8; ++j) x[ds][j] *= rn * qgain[32 * ds + 8 * g4 + j];
          if constexpr (DQK == 64) {
#pragma unroll
              for (int ds = 0; ds < 2; ++ds)
#pragma unroll
                  for (int j = 0; j < 8; ++j) {
                      auto rr = __builtin_amdgcn_permlane32_swap(__float_as_uint(x[ds][j]), __float_as_uint(x[ds][j]), false, false);
                      const float other = hi ? __uint_as_float(rr[0]) : __uint_as_float(rr[1]);
                      float cc = 1.f, sg = 0.f;
                      if (lat) { const f32x2 cs = rope[(ds ? pcol : prow) * 16 + 8 * (g4 & 1) + j]; cc = cs.x; sg = hi ? cs.y : -cs.y; }
                      x[ds][j] = x[ds][j] * cc + other * sg; }
          } else {
              float sr = 0.f;
#pragma unroll
              for (int j = 0; j < 8; ++j) sr += x[2][j] * x[2][j];
              sr = lanes4_sum(sr);
              const float rq = rsqrtf(sr * (1.f / 32.f) + EPS);
#pragma unroll
              for (int j = 0; j < 8; ++j) { const float av = x[2][j] * rq * qgain[64 + 8 * g4 + j];
                  auto rr = __builtin_amdgcn_permlane16_swap(__float_as_uint(av), __float_as_uint(av), false, false);
                  const float other = (g4 & 1) ? __uint_as_float(rr[0]) : __uint_as_float(rr[1]);
                  float cc = 1.f, sg = 0.f;
                  if (lat) { const f32x2 cs = rope[((g4 & 2) ? pcol : prow) * 8 + j]; cc = cs.x; sg = (g4 & 1) ? cs.y : -cs.y; }
                  x[2][j] = av * cc + other * sg; }
          }
#pragma unroll
          for (int ds = 0; ds < NDS; ++ds) { u32x4 w;
#pragma unroll
              for (int i = 0; i < 4; ++i) w[i] = cvtpk(x[ds][2 * i] * c2, x[ds][2 * i + 1] * c2);
              qf[qb * NDS + ds] = __builtin_bit_cast(bf16x8, w); }
      }
#pragma unroll
      for (int d0 = 0; d0 < NQB * NDS; ++d0) asm volatile("" : "+v"(qf[d0])); }
    wait_bar<0>();
    bf16x8 kf[NKW * NDS], vf[NVF];
    ATT_KLOAD(0);
    asm volatile("s_waitcnt lgkmcnt(0)\n\ts_barrier" ::: "memory");
    float lsum[NQB];
#pragma unroll
    for (int qb = 0; qb < NQB; ++qb) lsum[qb] = 0.f;
    const f32x4 zero4 = {0.f, 0.f, 0.f, 0.f};
    f32x4 o[NDB][NQB], c[NKW][NQB]; u32x4 pw[4];
#pragma unroll
    for (int i = 0; i < NDB; ++i)
#pragma unroll
        for (int qb = 0; qb < NQB; ++qb) o[i][qb] = zero4;
    ATT_DMA_K(3, 0); ATT_DMA_V(1, 1);
    ATT_QK(); ATT_SB();
    ATT_KLOAD(1); ATT_SB();
    if constexpr (LEAD) { ATT_EXP(); ATT_SUMPACK(); }
    wait_bar<NDMA>();
    int s_prev = 0, s_cur = 1, s_next = 2;
    int one_ = 1; asm volatile("" : "+s"(one_));
    for (int t = 1; t < NT; ++t) {
        __builtin_amdgcn_s_waitcnt(0xC07F);
        if constexpr (!LEAD) { ATT_EXP(); ATT_SUMPACK(); ATT_SB(); }
        ATT_VLOAD(s_prev, 0); ATT_SB();
        { const int tk = (t + 3 < NT) ? t + 3 : NT - 1; ATT_DMA_K(tk, s_cur); }
        { const int tv = (t + 1 < NT) ? t + 1 : NT - 1; ATT_DMA_V(tv, s_next); }
        ATT_SB();
        if constexpr (LEAD) {
            ATT_QK(); ATT_SB();
            ATT_PVP(0); ATT_SB();
            if constexpr (DV == 128) { ATT_VLOAD(s_prev, 1); ATT_SB(); ATT_EXP(); ATT_SB(); ATT_PVP(1); ATT_SB(); }
            if (one_) ATT_KLOAD(s_next);
            ATT_SB();
            if constexpr (DV == 64) ATT_EXP();
            ATT_SUMPACK();
            asm volatile("" : "+v"(pw[0]), "+v"(pw[1]), "+v"(pw[2]), "+v"(pw[3]));
#pragma unroll
            for (int qb = 0; qb < NQB; ++qb) asm volatile("" : "+v"(lsum[qb]));
        } else {
            if constexpr (DV == 128) {
                ATT_PVP(0); ATT_SB();
                ATT_VLOAD(s_prev, 1); ATT_SB();
                ATT_QK(); ATT_SB();
                if (one_) { ATT_KLOAD(s_next); ATT_SB(); ATT_PVP(1); }
                ATT_SB();
            } else {
                __builtin_amdgcn_s_setprio(1);
                ATT_QK(); ATT_SB();
                if (one_) { ATT_KLOAD(s_next); ATT_SB(); ATT_PVP(0); }
                ATT_SB();
                __builtin_amdgcn_s_setprio(0);
            }
#pragma unroll
            for (int kb = 0; kb < NKW; ++kb)
#pragma unroll
                for (int qb = 0; qb < NQB; ++qb) asm volatile("" : "+v"(c[kb][qb]));
        }
        ATT_SB();
        wait_bar<NDMA>();
        const int tmp = s_prev; s_prev = s_cur; s_cur = s_next; s_next = tmp;
    }
    if constexpr (!LEAD) { ATT_EXP(); ATT_SUMPACK(); ATT_SB(); }
    ATT_VLOAD(s_prev, 0); ATT_PVP(0);
    if constexpr (DV == 128) { ATT_SB(); ATT_VLOAD(s_prev, 1); ATT_PVP(1); }
#pragma unroll
    for (int qb = 0; qb < NQB; ++qb) lsum[qb] = lanes4_sum(lsum[qb]);
    if constexpr (KS) {
        wait_bar<0>();
        LAS unsigned char* xch = shm + (wid & 3) * 17408;
        if constexpr (!LEAD) {
#pragma unroll
            for (int db = 0; db < 4; ++db)
#pragma unroll
                for (int qb = 0; qb < 4; ++qb) *(LAS f32x4*)(xch + ((db * 4 + qb) * 64 + lane) * 16) = o[db][qb];
#pragma unroll
            for (int qb = 0; qb < 4; ++qb) *(LAS float*)(xch + 16384 + (qb * 64 + lane) * 4) = lsum[qb];
        }
        asm volatile("s_waitcnt lgkmcnt(0)\n\ts_barrier" ::: "memory");
        if constexpr (LEAD) {
            float inv[4];
#pragma unroll
            for (int qb = 0; qb < 4; ++qb) inv[qb] = 1.0f / (lsum[qb] + *(const LAS float*)(xch + 16384 + (qb * 64 + lane) * 4));
            LAS unsigned char* stg = shm + ATT_LDS + (wid & 3) * 8192;
#pragma unroll
            for (int dbl = 0; dbl < 4; ++dbl)
#pragma unroll
                for (int qb = 0; qb < 4; ++qb) { const f32x4 ov = o[dbl][qb] + *(const LAS f32x4*)(xch + ((dbl * 4 + qb) * 64 + lane) * 16); const int row = qb * 16 + q16;
                    u32x2 w; w.x = cvtpk(ov[0] * inv[qb], ov[1] * inv[qb]); w.y = cvtpk(ov[2] * inv[qb], ov[3] * inv[qb]);
                    *(LAS u32x2*)(stg + row * 128 + (((4 * dbl + g4) ^ ((row & 7) << 1)) << 3)) = w; }
            asm volatile("s_waitcnt lgkmcnt(0)" ::: "memory");
#pragma unroll
            for (int rr = 0; rr < 8; ++rr) { const int row = rr * 8 + (lane >> 3), ch = lane & 7;
                const u32x4 v = *(const LAS u32x4*)(stg + row * 128 + ((ch ^ (row & 7)) << 4));
                *(u32x4*)(O + (size_t)(qrow0 + qoff + row) * opitch + ch * 8) = v; }
            asm volatile("s_waitcnt lgkmcnt(0)" ::: "memory");
        }
    } else {
    const float inv[2] = {1.0f / lsum[0], 1.0f / lsum[1]};
    { LAS unsigned char* stg = shm + ATT_LDS + wid * 4096;
#pragma unroll
      for (int rnd = 0; rnd < DV / 64; ++rnd) {
#pragma unroll
        for (int dbl = 0; dbl < 4; ++dbl)
#pragma unroll
            for (int qb = 0; qb < 2; ++qb) { const f32x4 ov = o[rnd * 4 + dbl][qb]; const int row = qb * 16 + q16;
                u32x2 w; w.x = cvtpk(ov[0] * inv[qb], ov[1] * inv[qb]); w.y = cvtpk(ov[2] * inv[qb], ov[3] * inv[qb]);
                *(LAS u32x2*)(stg + row * 128 + (((4 * dbl + g4) ^ ((row & 7) << 1)) << 3)) = w; }
        asm volatile("s_waitcnt lgkmcnt(0)" ::: "memory");
#pragma unroll
        for (int rr = 0; rr < 4; ++rr) { const int row = rr * 8 + (lane >> 3), ch = lane & 7;
            const u32x4 v = *(const LAS u32x4*)(stg + row * 128 + ((ch ^ (row & 7)) << 4));
            *(u32x4*)(O + (size_t)(qrow0 + wid * 32 + row) * opitch + rnd * 64 + ch * 8) = v; }
        asm volatile("s_waitcnt lgkmcnt(0)" ::: "memory");
      } }
    }
    asm volatile("s_waitcnt lgkmcnt(0)\n\ts_barrier" ::: "memory");
#undef ATT_DMA_K
#undef ATT_DMA_V
#undef ATT_KLOAD
#undef ATT_QK
#undef ATT_VLOAD
#undef ATT_PVP
#undef ATT_EXP
#undef ATT_SUMPACK
}
template <int DQK, int DV>
__device__ __forceinline__ void attn_unit(const bf16_t* Q, int qpitch, const bf16_t* K, int kpitch, const bf16_t* KR, const bf16_t* Vt, bf16_t* O, int opitch,
                                          int qrow0, int krow0, int NT, LAS unsigned char* shm, const float* qgain, const f32x2* rope, int tq0) {
    if (__builtin_amdgcn_readfirstlane(threadIdx.x >> 6) < 4) attn_unit_impl<DQK, DV, true>(Q, qpitch, K, kpitch, KR, Vt, O, opitch, qrow0, krow0, NT, shm, qgain, rope, tq0);
    else attn_unit_impl<DQK, DV, false>(Q, qpitch, K, kpitch, KR, Vt, O, opitch, qrow0, krow0, NT, shm, qgain, rope, tq0);
}
#undef ATT_SB
}

struct Args { const float GAS* in[25]; float GAS* out; unsigned char GAS* ws; };
typedef const Args __attribute__((address_space(4)))* KArgs;
__device__ __forceinline__ KArgs launder(KArgs p) { asm volatile("" : "+s"(p)); return p; }
__device__ __forceinline__ const float* IN(KArgs a, int i) { return (const float*)a->in[i]; }
__device__ __forceinline__ float* OUTP(KArgs a) { return (float*)a->out; }
__device__ __forceinline__ unsigned char* WSP(KArgs a) { return (unsigned char*)a->ws; }
enum { I_X = 0, I_C, I_CTX, I_CCTX, I_WADA, I_BADA, I_NMIX, I_NFFN, I_WINE, I_AQK, I_DLAM, I_ASUB, I_BQK, I_WOUTE, I_WINO, I_QNORM, I_WQUP, I_KVNORM, I_WKVUP, I_QKNORM, I_WOUTO, I_WROUTER, I_WG, I_WU, I_WDN };
constexpr int CW_BAR = 4096;

struct Frame {
    LAS unsigned char* lds;
    int tid, lane, wave, vcu, G, gw, NGW;
};

__device__ __forceinline__ void ph_fence(Frame& F) {
    asm volatile("" : "+v"(F.tid));
    F.lane = F.tid & 63; F.wave = __builtin_amdgcn_readfirstlane(F.tid >> 6);
    asm volatile("" : "+s"(F.G), "+s"(F.vcu));
    F.gw = F.vcu * NWAVES + F.wave; F.NGW = F.G * NWAVES;
}
__device__ __forceinline__ float* xrow_ptr(float* xl, float* xc, int b, int t) { return (t < SEQ) ? xl + ((size_t)(b * SEQ + t)) * DM : xc + ((size_t)(b * CTXL + (t - SEQ))) * DM; }

__device__ __forceinline__ void transpose_item(const float* W, int ldw, int k0, int n0, bf16_t* dstrow0, int ldt, LAS float* scr, int lane) {
#pragma unroll 8
    for (int i = 0; i < 32; ++i) { const int kk = 2 * i + (lane >> 5); scr[kk * 33 + (lane & 31)] = W[(size_t)(k0 + kk) * ldw + n0 + (lane & 31)]; }
    LDS_WAIT(); asm volatile("" ::: "memory");
    const int c = lane & 7;
#pragma unroll
    for (int j = 0; j < 4; ++j) { const int n = (lane >> 3) + 8 * j; const LAS float* s = scr + (8 * c) * 33 + n;
        u32x4 o; o.x = cvtpk(s[0 * 33], s[1 * 33]); o.y = cvtpk(s[2 * 33], s[3 * 33]); o.z = cvtpk(s[4 * 33], s[5 * 33]); o.w = cvtpk(s[6 * 33], s[7 * 33]);
        *(u32x4*)(dstrow0 + (size_t)n * ldt + k0 + 8 * c) = o; }
    LDS_WAIT(); asm volatile("" ::: "memory");
}

__device__ __forceinline__ void p0_phase(Frame& F, KArgs a) {
    ph_fence(F);
    unsigned char* ws = WSP(a);
    float* MOD = (float*)(ws + WS_MOD);
    LAS float* sc = (LAS float*)F.lds;
    LAS float* part = (LAS float*)(F.lds + 40960);
    for (int i = F.tid; i < 9 * 1024; i += 512) { const float v = (i < 8192) ? IN(a, I_C)[i] : IN(a, I_CCTX)[i - 8192]; sc[i] = v / (1.f + __expf(-v)); }
    __syncthreads();
    for (int it = blockIdx.x; it < 4 * 192; it += F.G) {
        const int L = it / 192, cb = it - L * 192, col = cb * 32 + (F.lane & 31);
        const float* wp = IN(a, I_WADA) + (size_t)L * 1024 * 6144 + col;
        float acc[9];
#pragma unroll
        for (int s = 0; s < 9; ++s) acc[s] = 0.f;
        const int kb = F.wave * 128 + (F.lane >> 5) * 64;
#pragma unroll 1
        for (int k0 = 0; k0 < 64; k0 += 32) {
            float w[32];
#pragma unroll
            for (int j = 0; j < 32; ++j) w[j] = wp[(size_t)(kb + k0 + j) * 6144];
#pragma unroll
            for (int k = 0; k < 32; k += 4)
#pragma unroll
                for (int s = 0; s < 9; ++s) { const f32x4 sv = *(const LAS f32x4*)(sc + s * 1024 + kb + k0 + k); acc[s] += sv[0] * w[k] + sv[1] * w[k + 1] + sv[2] * w[k + 2] + sv[3] * w[k + 3]; }
        }
#pragma unroll
        for (int s = 0; s < 9; ++s) part[(F.wave * 9 + s) * 64 + F.lane] = acc[s];
        __syncthreads();
        for (int i = F.tid; i < 9 * 32; i += 512) { const int s = i >> 5, l = i & 31; float v = 0.f;
#pragma unroll
            for (int w = 0; w < 8; ++w) v += part[(w * 9 + s) * 64 + l] + part[(w * 9 + s) * 64 + 32 + l];
            const int cc = cb * 32 + l;
            MOD[((size_t)(L * 9 + s) * 6) * 1024 + cc] = v + IN(a, I_BADA)[L * 6144 + cc]; }
        __syncthreads();
    }
    { float* r64 = (float*)(ws + WS_ROPE64); float* r32t = (float*)(ws + WS_ROPE32);
      for (int i = blockIdx.x * 512 + F.tid; i < 128 * 16 + 128 * 8; i += F.G * 512) {
          if (i < 2048) { const int pos = i >> 4, j = i & 15; const float f = powf(10000.f, -(float)j / 16.f); const float ang = (float)pos * f; r64[2 * i] = cosf(ang); r64[2 * i + 1] = sinf(ang); }
          else { const int q = i - 2048, pos = q >> 3, j = q & 7; const float f = powf(10000.f, -(float)j / 8.f); const float ang = (float)pos * f; r32t[2 * q] = cosf(ang); r32t[2 * q + 1] = sinf(ang); } } }
    { bf16_t* wqk = (bf16_t*)(ws + WS_WQK); bf16_t* wve = (bf16_t*)(ws + WS_WVE); bf16_t* wino = (bf16_t*)(ws + WS_WINO); bf16_t* wkn = (bf16_t*)(ws + WS_WKN); bf16_t* wvo = (bf16_t*)(ws + WS_WVO);
      const int gt = blockIdx.x * 512 + F.tid, NT_ = F.G * 512; const u32x4 z = {0u, 0u, 0u, 0u};
      for (int i = gt; i < 2 * 128 * 128; i += NT_) { const int j = i / (128 * 128), q = i - j * 128 * 128; *(u32x4*)(wqk + ((size_t)j * QKW + 1664) * 1024 + q * 8) = z; *(u32x4*)(wve + ((size_t)j * VEW + 640) * 1024 + q * 8) = z; }
      for (int i = gt; i < 2 * 96 * 128; i += NT_) { const int j = i / (96 * 128), q = i - j * 96 * 128; *(u32x4*)(wino + ((size_t)j * 512 + 416) * 1024 + q * 8) = z; }
      for (int i = gt; i < 2 * 1024 * 16; i += NT_) { const int row = i >> 4, q = i & 15; *(u32x4*)(wkn + (size_t)row * 256 + 128 + q * 8) = z; *(u32x4*)(wvo + (size_t)row * 256 + 128 + q * 8) = z; } }
    LAS float* scr = (LAS float*)(F.lds + 61440 + F.wave * 8448);
    constexpr int IE_IN = 16 * 72, IE_OUT = 16 * 32, IO_IN = 16 * 13, IO_QUP = 4 * 48, IO_KV = 2 * 64, IO_OUT = 16 * 32;
    constexpr int PER_J = IE_IN + IE_OUT + IO_IN + IO_QUP + IO_KV + IO_OUT;
    for (int it = F.gw; it < 2 * PER_J; it += F.NGW) {
        const int j = it / PER_J; int r = it - j * PER_J;
        if (r < IE_IN) { const int kb = r / 72, nb = r - kb * 72, n0 = nb * 32;
            bf16_t* dst;
            if (n0 < 1024) dst = (bf16_t*)(ws + WS_WQK) + ((size_t)j * QKW + n0) * 1024;
            else if (n0 < 1536) dst = (bf16_t*)(ws + WS_WVE) + ((size_t)j * VEW + (n0 - 1024)) * 1024;
            else if (n0 < 2176) dst = (bf16_t*)(ws + WS_WQK) + ((size_t)j * QKW + 1024 + (n0 - 1536)) * 1024;
            else dst = (bf16_t*)(ws + WS_WVE) + ((size_t)j * VEW + 512 + (n0 - 2176)) * 1024;
            transpose_item(IN(a, I_WINE) + (size_t)j * 1024 * 2304, 2304, kb * 64, n0, dst, 1024, scr, F.lane); continue; } r -= IE_IN;
        if (r < IE_OUT) { const int kb = r / 32, nb = r - kb * 32;
            transpose_item(IN(a, I_WOUTE) + (size_t)j * 1024 * 1024, 1024, kb * 64, nb * 32, (bf16_t*)(ws + WS_WOE) + ((size_t)j * 1024 + nb * 32) * 1024, 1024, scr, F.lane); continue; } r -= IE_OUT;
        if (r < IO_IN) { const int kb = r / 13, nb = r - kb * 13;
            transpose_item(IN(a, I_WINO) + (size_t)j * 1024 * 416, 416, kb * 64, nb * 32, (bf16_t*)(ws + WS_WINO) + ((size_t)j * 512 + nb * 32) * 1024, 1024, scr, F.lane); continue; } r -= IO_IN;
        if (r < IO_QUP) { const int kb = r / 48, nb = r - kb * 48;
            transpose_item(IN(a, I_WQUP) + (size_t)j * 256 * 1536, 1536, kb * 64, nb * 32, (bf16_t*)(ws + WS_WQUP) + ((size_t)j * 1536 + nb * 32) * 256, 256, scr, F.lane); continue; } r -= IO_QUP;
        if (r < IO_KV) { const int kb = r / 64, nb = r - kb * 64, n0 = nb * 32, h = n0 >> 7, w = n0 & 127;
            bf16_t* dst = (w < 64) ? (bf16_t*)(ws + WS_WKN) + ((size_t)j * 1024 + h * 64 + w) * 256 : (bf16_t*)(ws + WS_WVO) + ((size_t)j * 1024 + h * 64 + (w - 64)) * 256;
            transpose_item(IN(a, I_WKVUP) + (size_t)j * 128 * 2048, 2048, kb * 64, n0, dst, 256, scr, F.lane); continue; } r -= IO_KV;
        { const int kb = r / 32, nb = r - kb * 32;
            transpose_item(IN(a, I_WOUTO) + (size_t)j * 1024 * 1024, 1024, kb * 64, nb * 32, (bf16_t*)(ws + WS_WOO) + ((size_t)j * 1024 + nb * 32) * 1024, 1024, scr, F.lane); }
    }
}
__device__ __forceinline__ void convert_experts(Frame& F, KArgs a, int L) {
    ph_fence(F);
    LAS float* scr = (LAS float*)(F.lds + 61440 + F.wave * 8448);
    bf16_t* wgu = (bf16_t*)(WSP(a) + WS_WGU); bf16_t* wd = (bf16_t*)(WSP(a) + WS_WD);
    for (int it = F.gw; it < 3 * 8192; it += F.NGW) {
        const int which = it >> 13, r = it & 8191, e = r >> 9, q = r & 511, kb = q >> 5, nb = q & 31, n0 = nb * 32;
        const float* src = IN(a, which == 0 ? I_WG : (which == 1 ? I_WU : I_WDN)) + ((size_t)(L * 16 + e)) * 1024 * 1024;
        bf16_t* dst = (which == 2) ? wd + ((size_t)e * 1024 + n0) * 1024 : wgu + ((size_t)e * 2048 + (n0 >> 7) * 256 + (n0 & 127) + (which == 1 ? 128 : 0)) * 1024;
        transpose_item(src, 1024, kb * 64, n0, dst, 1024, scr, F.lane);
    }
}

__device__ __forceinline__ void norm1_phase(Frame& F, KArgs a, int L) {
    ph_fence(F);
    unsigned char* ws = WSP(a);
    float* xl = OUTP(a); float* xc = (float*)(ws + WS_XCTX);
    const float* MOD = (const float*)(ws + WS_MOD);
    bf16_t* H = (bf16_t*)(ws + WS_H);
    const float* AFF = (const float*)(ws + WS_AFF); const int* SLOT = (const int*)(ws + WS_SLOT); const bf16_t* Y = (const bf16_t*)(ws + WS_Y);
    const float* xin = IN(a, I_X); const float* cin = IN(a, I_CTX); const float* gnm = IN(a, I_NMIX) + (L < 4 ? L : 0) * 1024;
    const int lane = F.lane;
    constexpr int RB = 2;
    for (int r0 = F.gw; r0 < NR; r0 += RB * F.NGW) {
        f32x4 v[RB][4]; int sl[RB]; float af[RB]; float* xr[RB]; bool ok[RB]; int ss[RB], rw[RB];
#pragma unroll
        for (int k = 0; k < RB; ++k) {
            int r = r0 + k * F.NGW; ok[k] = r < NR; if (!ok[k]) r = r0;
            const int b = r / TPS, t = r - b * TPS; const bool isctx = t >= SEQ; ss[k] = isctx ? 8 : b; rw[k] = r;
            if (L == 4 && isctx) ok[k] = false;
            xr[k] = xrow_ptr(xl, xc, b, t);
            const float* src = (L == 0) ? (isctx ? cin + ((size_t)(b * CTXL + t - SEQ)) * DM : xin + ((size_t)(b * SEQ + t)) * DM) : xr[k];
#pragma unroll
            for (int j = 0; j < 4; ++j) v[k][j] = *(const f32x4*)(src + 256 * j + 4 * lane);
            sl[k] = -1; af[k] = 0.f;
            if (L > 0 && lane < 16) { sl[k] = SLOT[(size_t)r * 16 + lane]; af[k] = AFF[(size_t)r * 16 + lane]; }
        }
#pragma unroll
        for (int k = 0; k < RB; ++k) {
            if (!ok[k]) continue;
            if (L > 0) {
                f32x4 acc[4];
#pragma unroll
                for (int j = 0; j < 4; ++j) acc[j] = (f32x4){0.f, 0.f, 0.f, 0.f};
                unsigned mask = (unsigned)__ballot(sl[k] >= 0) & 0xffffu;
                while (mask) {
                    int pq[4]; float gq[4];
#pragma unroll
                    for (int q = 0; q < 4; ++q) {
                        if (mask) { const int e = __builtin_ctz(mask); mask &= mask - 1u; pq[q] = __builtin_amdgcn_readlane(sl[k], e); gq[q] = __uint_as_float(__builtin_amdgcn_readlane(__float_as_uint(af[k]), e)); }
                        else { pq[q] = pq[0]; gq[q] = 0.f; }
                    }
                    u32x2 y[4][4];
#pragma unroll
                    for (int q = 0; q < 4; ++q)
#pragma unroll
                        for (int j = 0; j < 4; ++j) y[q][j] = *(const u32x2*)(Y + (size_t)pq[q] * DM + 256 * j + 4 * lane);
#pragma unroll
                    for (int q = 0; q < 4; ++q)
#pragma unroll
                        for (int j = 0; j < 4; ++j) { acc[j][0] += gq[q] * bf_lo(y[q][j].x); acc[j][1] += gq[q] * bf_hi(y[q][j].x); acc[j][2] += gq[q] * bf_lo(y[q][j].y); acc[j][3] += gq[q] * bf_hi(y[q][j].y); }
                }
                const float* m5 = MOD + ((size_t)((L - 1) * 9 + ss[k]) * 6 + 5) * 1024;
#pragma unroll
                for (int j = 0; j < 4; ++j) v[k][j] += *(const f32x4*)(m5 + 256 * j + 4 * lane) * acc[j];
            }
#pragma unroll
            for (int j = 0; j < 4; ++j) *(f32x4*)(xr[k] + 256 * j + 4 * lane) = v[k][j];
            if (L == 4) continue;
            float sq = 0.f;
#pragma unroll
            for (int j = 0; j < 4; ++j) sq += (v[k][j][0] * v[k][j][0] + v[k][j][1] * v[k][j][1]) + (v[k][j][2] * v[k][j][2] + v[k][j][3] * v[k][j][3]);
            const float rstd = rsqrtf(wave_sum(sq) * (1.f / DM) + EPS);
            const float* sh = MOD + ((size_t)(L * 9 + ss[k]) * 6 + 0) * 1024; const float* scl = sh + 1024;
            bf16_t* hr = H + (size_t)rw[k] * DM;
#pragma unroll
            for (int j = 0; j < 4; ++j) { const int c = 256 * j + 4 * lane; const f32x4 g = *(const f32x4*)(gnm + c), sf = *(const f32x4*)(sh + c), sc = *(const f32x4*)(scl + c);
                f32x4 h = (v[k][j] * rstd) * g * (sc + 1.f) + sf; u32x2 w; w.x = cvtpk(h[0], h[1]); w.y = cvtpk(h[2], h[3]); *(u32x2*)(hr + c) = w; }
            asm volatile("" ::: "memory");
        }
    }
}

__device__ __forceinline__ void build_router_mod(Frame& F, KArgs a, int L) {
    unsigned char* ws = WSP(a);
    const float* MOD = (const float*)(ws + WS_MOD); const float* wr = IN(a, I_WROUTER) + (size_t)L * 1024 * 16; const float* gn = IN(a, I_NFFN) + L * 1024;
    float* WP = (float*)(ws + WS_WP); float* BI = WP + 9 * 16384;
    for (int idx = F.gw * 64 + F.lane; idx < 9 * 16384; idx += F.NGW * 64) {
        const int s_ = idx >> 14, rem = idx & 16383, i = rem & 3, e = (rem >> 2) & 15, kq = (rem >> 6) & 3, j = rem >> 8, k = 16 * j + 4 * kq + i;
        const float* scl = MOD + ((size_t)(L * 9 + s_) * 6 + 4) * 1024;
        WP[idx] = wr[k * 16 + e] * gn[k] * (1.f + scl[k]); }
    for (int d = F.gw; d < 144; d += F.NGW) { const int s_ = d >> 4, e = d & 15; const float* sh = MOD + ((size_t)(L * 9 + s_) * 6 + 3) * 1024;
        float p = 0.f;
        for (int k = F.lane; k < 1024; k += 64) p += sh[k] * wr[k * 16 + e];
        p = wave_sum(p); if (F.lane == 0) BI[d] = p; }
}
__device__ __forceinline__ void norm2_block(float* xl, float* xc, const float* MOD, const float* gn, const float* WP, bf16_t* H, float* AFF, int L, int row0, int nrows, int lane) {
    const int r16 = lane & 15, kq = lane >> 4;
    const int b = row0 / TPS, t0 = row0 - b * TPS; const int s_ = (t0 >= SEQ) ? 8 : b;
    if (L == 3 && t0 >= SEQ) return;
    const int rl = (r16 < nrows) ? r16 : r16 - nrows;
    const float* xr = xrow_ptr(xl, xc, b, t0 + rl) + 4 * kq;
    const float* wp = WP + s_ * 16384 + (kq * 16 + r16) * 4;
    f32x4 acc = {0.f, 0.f, 0.f, 0.f}; float sq = 0.f;
    f32x4 xa[8], wb[8];
#pragma unroll
    for (int q = 0; q < 8; ++q) { xa[q] = *(const f32x4*)(xr + 16 * q); wb[q] = *(const f32x4*)(wp + 256 * q); }
#pragma unroll
    for (int g = 0; g < 8; ++g) {
        f32x4 xn[8], wn[8];
        if (g < 7) {
#pragma unroll
            for (int q = 0; q < 8; ++q) { xn[q] = *(const f32x4*)(xr + 16 * (8 * (g + 1) + q)); wn[q] = *(const f32x4*)(wp + 256 * (8 * (g + 1) + q)); } }
#pragma unroll
        for (int q = 0; q < 8; ++q) {
            sq += (xa[q][0] * xa[q][0] + xa[q][1] * xa[q][1]) + (xa[q][2] * xa[q][2] + xa[q][3] * xa[q][3]);
#pragma unroll
            for (int i = 0; i < 4; ++i) acc = __builtin_amdgcn_mfma_f32_16x16x4f32(xa[q][i], wb[q][i], acc, 0, 0, 0); }
        if (g < 7) {
#pragma unroll
            for (int q = 0; q < 8; ++q) { xa[q] = xn[q]; wb[q] = wn[q]; } }
    }
    sq = att::lanes4_sum(sq);
    const float rstd = rsqrtf(sq * (1.f / DM) + EPS);
    const float bias = WP[9 * 16384 + s_ * 16 + r16];
#pragma unroll
    for (int i = 0; i < 4; ++i) {
        const float rs = __shfl(rstd, 4 * kq + i);
        const float lg = acc[i] * rs + bias;
        float mx = lg;
#pragma unroll
        for (int o = 1; o < 16; o <<= 1) mx = fmaxf(mx, __shfl_xor(mx, o));
        const float mine = __expf(lg - mx); float den = mine;
#pragma unroll
        for (int o = 1; o < 16; o <<= 1) den += __shfl_xor(den, o);
        if (4 * kq + i < nrows) AFF[(size_t)(row0 + 4 * kq + i) * 16 + r16] = mine / den;
    }
    const float* sh = MOD + ((size_t)(L * 9 + s_) * 6 + 3) * 1024; const float* scl = sh + 1024;
    f32x4 mg[4], sf[4];
#pragma unroll
    for (int j = 0; j < 4; ++j) { const int c = 256 * j + 4 * lane; mg[j] = *(const f32x4*)(gn + c) * (*(const f32x4*)(scl + c) + 1.f); sf[j] = *(const f32x4*)(sh + c); }
#pragma unroll
    for (int r4 = 0; r4 < 4; ++r4) {
        if (r4 * 4 < nrows) {
            f32x4 v[4][4];
#pragma unroll
            for (int k = 0; k < 4; ++k) { const float* xq = xrow_ptr(xl, xc, b, t0 + r4 * 4 + k);
#pragma unroll
                for (int j = 0; j < 4; ++j) v[k][j] = *(const f32x4*)(xq + 256 * j + 4 * lane); }
#pragma unroll
            for (int k = 0; k < 4; ++k) { const float rs = __builtin_bit_cast(float, __builtin_amdgcn_readlane(__builtin_bit_cast(int, rstd), r4 * 4 + k));
                bf16_t* hr = H + (size_t)(row0 + r4 * 4 + k) * DM;
#pragma unroll
                for (int j = 0; j < 4; ++j) { const f32x4 h = (v[k][j] * rs) * mg[j] + sf[j]; u32x2 w; w.x = cvtpk(h[0], h[1]); w.y = cvtpk(h[2], h[3]); *(u32x2*)(hr + 256 * j + 4 * lane) = w; } }
            asm volatile("" ::: "memory");
        }
    }
}
__device__ __forceinline__ void norm2_router_phase(Frame& F, KArgs a, int L) {
    ph_fence(F);
    unsigned char* ws = WSP(a);
    float* xl = OUTP(a); float* xc = (float*)(ws + WS_XCTX);
    const float* MOD = (const float*)(ws + WS_MOD); const float* WP = (const float*)(ws + WS_WP);
    bf16_t* H = (bf16_t*)(ws + WS_H); float* AFF = (float*)(ws + WS_AFF);
    const float* gn = IN(a, I_NFFN) + L * 1024;
    constexpr int NBLK = NR / 16;
    const int nfull = (NBLK / F.NGW) * F.NGW;
    if (F.wave == 0)
        for (int hb = F.vcu; hb < 2 * (NBLK - nfull); hb += F.G) norm2_block(xl, xc, MOD, gn, WP, H, AFF, L, nfull * 16 + hb * 8, 8, F.lane);
    for (int blk = nfull - 1 - F.gw; blk >= 0; blk -= F.NGW) norm2_block(xl, xc, MOD, gn, WP, H, AFF, L, blk * 16, 16, F.lane);
}

__device__ __forceinline__ void topk_phase(Frame& F, KArgs a, int nsets) {
    ph_fence(F);
    unsigned char* ws = WSP(a);
    const float* AFF = (const float*)(ws + WS_AFF); int* SLOT = (int*)(ws + WS_SLOT); int* TOK = (int*)(ws + WS_TOK);
    LAS unsigned* keys = (LAS unsigned*)F.lds;
    LAS unsigned* hist = keys + 8192;
    LAS unsigned* misc = hist + 256;
    LAS unsigned* wtot = misc + 8;
    const int tid = F.tid, lane = F.lane;
    for (int sidx = blockIdx.x; sidx < nsets; sidx += F.G) {
        const bool lat = sidx < 128; const int k = lat ? sidx : sidx - 128, b = k >> 4, e = k & 15;
        const int row0 = b * TPS + (lat ? 0 : SEQ), n = lat ? SEQ : CTXL, cap = lat ? CAP_L : CAP_C;
        const int pairbase = lat ? (b * 16 + e) * CAP_L : NPAIR_L + e * (NB * CAP_C) + b * CAP_C;
        for (int i = tid; i < n; i += 512) keys[i] = __float_as_uint(AFF[(size_t)(row0 + i) * 16 + e]);
        if (tid == 0) { misc[0] = 0u; misc[1] = (unsigned)cap; }
        __syncthreads();
        for (int round = 0; round < 4; ++round) {
            const int shift = 24 - 8 * round;
            if (tid < 256) hist[tid] = 0u;
            __syncthreads();
            const unsigned prefix = misc[0], need = misc[1];
            for (int i = tid; i < n; i += 512) { const unsigned kk = keys[i]; if (round == 0 || (kk >> (shift + 8)) == prefix) atomicAdd((unsigned*)&hist[(kk >> shift) & 255u], 1u); }
            __syncthreads();
            if (tid < 64) {
                unsigned h[4]; unsigned ssum = 0u;
#pragma unroll
                for (int j = 0; j < 4; ++j) { h[j] = hist[255 - 4 * lane - j]; ssum += h[j]; }
                unsigned incl = ssum;
#pragma unroll
                for (int o = 1; o < 64; o <<= 1) { const unsigned tt = __shfl_up(incl, o); if (lane >= o) incl += tt; }
                unsigned c = incl - ssum;
#pragma unroll
                for (int j = 0; j < 4; ++j) { if (c < need && need <= c + h[j]) { misc[0] = (prefix << 8) | (unsigned)(255 - 4 * lane - j); misc[1] = need - c; } c += h[j]; }
            }
            __syncthreads();
        }
        const unsigned T = misc[0], need_eq = misc[1];
        const int chunk = (n + 511) / 512, i0 = tid * chunk;
        unsigned cg = 0u, ce = 0u;
        for (int i = 0; i < chunk; ++i) { const int idx = i0 + i; if (idx < n) { const unsigned kk = keys[idx]; cg += (kk > T) ? 1u : 0u; ce += (kk == T) ? 1u : 0u; } }
        const unsigned packed = cg | (ce << 16);
        unsigned incl = packed;
#pragma unroll
        for (int o = 1; o < 64; o <<= 1) { const unsigned tt = __shfl_up(incl, o); if (lane >= o) incl += tt; }
        if (lane == 63) wtot[F.wave] = incl;
        __syncthreads();
        unsigned wbase = 0u;
        for (int w = 0; w < F.wave; ++w) wbase += wtot[w];
        const unsigned excl = wbase + incl - packed;
        unsigned g = excl & 0xffffu, q = excl >> 16;
        for (int i = 0; i < chunk; ++i) { const int idx = i0 + i; if (idx < n) { const unsigned kk = keys[idx]; int slot = -1;
                if (kk > T) { slot = (int)(g + (q < need_eq ? q : need_eq)); ++g; }
                else if (kk == T) { if (q < need_eq) slot = (int)(g + q); ++q; }
                const int row = row0 + idx;
                if (slot >= 0) { TOK[pairbase + slot] = row; SLOT[(size_t)row * 16 + e] = pairbase + slot; } else SLOT[(size_t)row * 16 + e] = -1; } }
        __syncthreads();
    }
}

__device__ __forceinline__ void even_qk_phase(Frame& F, KArgs a, int j) {
    ph_fence(F);
    unsigned char* ws = WSP(a);
    bf16_t* QK = (bf16_t*)(ws + WS_QK); const f32x2* R64 = (const f32x2*)(ws + WS_ROPE64);
    const float* aqk = IN(a, I_AQK) + j * 128; const float* bqk = IN(a, I_BQK) + j * 128;
    const int lane = F.lane, q4 = lane & 3, hl = lane >> 2;
    const int d1 = (q4 >> 1) * 32 + (q4 & 1) * 8, d2 = d1 + 16;
    const bool hact = hl < 10; const int hc = hl < 8 ? 8 + hl : (hl < 10 ? 16 + hl : 8);
    const float* gain = (hc < 16) ? aqk + 64 : bqk + 64;
    float g1[8], g2[8];
#pragma unroll
    for (int i = 0; i < 8; ++i) { g1[i] = gain[d1 + i]; g2[i] = gain[d2 + i]; }
    constexpr int RB = 4;
    for (int r0 = F.gw + ((NR - 1 - F.gw) / (RB * F.NGW)) * (RB * F.NGW); r0 >= 0; r0 -= RB * F.NGW) {
        u32x4 w1[RB], w2[RB]; bool ok[RB]; int tt[RB]; bf16_t* rowp[RB];
#pragma unroll
        for (int k = 0; k < RB; ++k) {
            int r = r0 + k * F.NGW; ok[k] = r < NR; if (!ok[k]) r = r0;
            const int b = r / TPS; tt[k] = r - b * TPS; rowp[k] = QK + (size_t)r * QKW + hc * 64;
            w1[k] = *(const u32x4*)(rowp[k] + d1); w2[k] = *(const u32x4*)(rowp[k] + d2);
        }
#pragma unroll
        for (int k = 0; k < RB; ++k) {
            const int t = tt[k]; const bool lat = t < SEQ; const int pos = (q4 >> 1) ? (t & 63) : (t >> 6);
            float x1[8], x2[8];
#pragma unroll
            for (int i = 0; i < 4; ++i) { x1[2 * i] = bf_lo(w1[k][i]); x1[2 * i + 1] = bf_hi(w1[k][i]); x2[2 * i] = bf_lo(w2[k][i]); x2[2 * i + 1] = bf_hi(w2[k][i]); }
            float ss = 0.f;
#pragma unroll
            for (int i = 0; i < 8; ++i) ss += x1[i] * x1[i] + x2[i] * x2[i];
            ss += __shfl_xor(ss, 1); ss += __shfl_xor(ss, 2);
            const float rstd = rsqrtf(ss * (1.f / 64.f) + EPS);
            float o1[8], o2[8];
#pragma unroll
            for (int i = 0; i < 8; ++i) {
                const float a1 = x1[i] * rstd * g1[i], a2 = x2[i] * rstd * g2[i];
                float c = 1.f, s_ = 0.f;
                if (lat) { const f32x2 cs = R64[pos * 16 + (q4 & 1) * 8 + i]; c = cs.x; s_ = cs.y; }
                o1[i] = a1 * c - a2 * s_; o2[i] = a2 * c + a1 * s_;
            }
            if (hact && ok[k]) { u32x4 u1, u2;
#pragma unroll
                for (int i = 0; i < 4; ++i) { u1[i] = cvtpk(o1[2 * i], o1[2 * i + 1]); u2[i] = cvtpk(o2[2 * i], o2[2 * i + 1]); }
                *(u32x4*)(rowp[k] + d1) = u1; *(u32x4*)(rowp[k] + d2) = u2; }
        }
    }
}
__device__ __forceinline__ void even_merge_phase(Frame& F, KArgs a, int j, int layer) {
    ph_fence(F);
    unsigned char* ws = WSP(a);
    const bf16_t* OB = (const bf16_t*)(ws + WS_OB); bf16_t* H = (bf16_t*)(ws + WS_H);
    const float lam_init = 0.8f - 0.6f * expf(-0.3f * (float)layer);
    const float* lv = IN(a, I_DLAM) + j * 256;
    const float s01 = wave_sum(lv[F.lane] * lv[64 + F.lane]), s23 = wave_sum(lv[128 + F.lane] * lv[192 + F.lane]);
    const float lam = expf(s01) - expf(s23) + lam_init;
    const float* sub = IN(a, I_ASUB) + j * 128;
    const int lane = F.lane, hd = lane >> 4, sb = lane & 15;
    float gsub[8];
#pragma unroll
    for (int i = 0; i < 8; ++i) gsub[i] = sub[sb * 8 + i] * (1.f - lam_init);
    constexpr int RB = 4;
    for (int r0 = F.gw; r0 < NR; r0 += RB * F.NGW) {
        u32x4 w1[RB], w2[RB]; bool ok[RB]; int rw[RB];
#pragma unroll
        for (int k = 0; k < RB; ++k) { int r = r0 + k * F.NGW; ok[k] = r < NR; if (!ok[k]) r = r0; rw[k] = r;
            const bf16_t* p1 = OB + (size_t)r * 1024 + (hd * 2) * 128 + sb * 8; w1[k] = *(const u32x4*)p1; w2[k] = *(const u32x4*)(p1 + 128); }
#pragma unroll
        for (int k = 0; k < RB; ++k) {
            float v[8]; float ss = 0.f;
#pragma unroll
            for (int i = 0; i < 4; ++i) { v[2 * i] = bf_lo(w1[k][i]) - lam * bf_lo(w2[k][i]); v[2 * i + 1] = bf_hi(w1[k][i]) - lam * bf_hi(w2[k][i]); }
#pragma unroll
            for (int i = 0; i < 8; ++i) ss += v[i] * v[i];
            ss += __shfl_xor(ss, 1); ss += __shfl_xor(ss, 2); ss += __shfl_xor(ss, 4); ss += __shfl_xor(ss, 8);
            const float rstd = rsqrtf(ss * (1.f / 128.f) + EPS);
            u32x4 u;
#pragma unroll
            for (int i = 0; i < 4; ++i) u[i] = cvtpk(v[2 * i] * rstd * gsub[2 * i], v[2 * i + 1] * rstd * gsub[2 * i + 1]);
            if (ok[k]) *(u32x4*)(H + (size_t)rw[k] * 1024 + hd * 128 + sb * 8) = u;
        }
    }
}
__device__ __forceinline__ void odd_c_phase(Frame& F, KArgs a, int j) {
    ph_fence(F);
    unsigned char* ws = WSP(a);
    const float* CR = (const float*)(ws + WS_CRAW); bf16_t* CN = (bf16_t*)(ws + WS_CN); bf16_t* KR = (bf16_t*)(ws + WS_KR); const f32x2* R32 = (const f32x2*)(ws + WS_ROPE32);
    const float* qn = IN(a, I_QNORM) + j * 256; const float* kvn = IN(a, I_KVNORM) + j * 128; const float* qkn = IN(a, I_QKNORM) + j * 192;
    const int lane = F.lane;
    const f32x4 gq = *(const f32x4*)(qn + 4 * lane); const f32x2 gkv = *(const f32x2*)(kvn + 2 * lane); const float gkr = qkn[96 + 64 + (lane & 31)];
    constexpr int RB = 4;
    for (int r0 = F.gw; r0 < NR; r0 += RB * F.NGW) {
        f32x4 cq[RB]; f32x2 ckv[RB]; float kr[RB]; bool ok[RB]; int rw[RB];
#pragma unroll
        for (int k = 0; k < RB; ++k) { int r = r0 + k * F.NGW; ok[k] = r < NR; if (!ok[k]) r = r0; rw[k] = r;
            const float* cr = CR + (size_t)r * 512;
            cq[k] = *(const f32x4*)(cr + 4 * lane); ckv[k] = *(const f32x2*)(cr + 256 + 2 * lane); kr[k] = (lane < 32) ? cr[384 + lane] : 0.f; }
#pragma unroll
        for (int k = 0; k < RB; ++k) {
            const int r = rw[k]; const int b = r / TPS, t = r - b * TPS; const bool lat = t < SEQ;
            const float sq = wave_sum((cq[k][0] * cq[k][0] + cq[k][1] * cq[k][1]) + (cq[k][2] * cq[k][2] + cq[k][3] * cq[k][3]));
            const float skv = wave_sum(ckv[k][0] * ckv[k][0] + ckv[k][1] * ckv[k][1]);
            const float skr = wave_sum(kr[k] * kr[k]);
            const float rq = rsqrtf(sq * (1.f / 256.f) + EPS), rkv = rsqrtf(skv * (1.f / 128.f) + EPS), rkr = rsqrtf(skr * (1.f / 32.f) + EPS);
            bf16_t* cn = CN + (size_t)r * CNW;
            float kv = kr[k] * rkr * gkr;
            const float partner = __shfl_xor(kv, 8);
            if (lat) { const int pos = (lane & 16) ? (t & 63) : (t >> 6); const f32x2 cs = R32[pos * 8 + (lane & 7)];
                kv = (lane & 8) ? (kv * cs.x + partner * cs.y) : (kv * cs.x - partner * cs.y); }
            const float other = __shfl_down(kv, 1);
            if (ok[k]) {
                u32x2 w; w.x = cvtpk(cq[k][0] * rq * gq[0], cq[k][1] * rq * gq[1]); w.y = cvtpk(cq[k][2] * rq * gq[2], cq[k][3] * rq * gq[3]); *(u32x2*)(cn + 4 * lane) = w;
                *(unsigned*)(cn + 256 + 2 * lane) = cvtpk(ckv[k][0] * rkv * gkv[0], ckv[k][1] * rkv * gkv[1]);
                *(unsigned*)(cn + 384 + 2 * lane) = 0u;
                if (lane < 32 && !(lane & 1)) *(unsigned*)(KR + (size_t)r * 32 + lane) = cvtpk(kv, other);
            }
        }
    }
}
__device__ __forceinline__ void odd_qk_phase(Frame& F, KArgs a, int j) {
    ph_fence(F);
    unsigned char* ws = WSP(a);
    bf16_t* KN = (bf16_t*)(ws + WS_KN);
    const float* qkn = IN(a, I_QKNORM) + j * 192;
    const int lane = F.lane, q4 = lane & 3, hd = lane >> 2;
    float gkn[16];
#pragma unroll
    for (int i = 0; i < 16; ++i) gkn[i] = qkn[96 + q4 * 16 + i];
    constexpr int RB = 4;
    for (int r0 = F.gw + ((NR - 1 - F.gw) / (RB * F.NGW)) * (RB * F.NGW); r0 >= 0; r0 -= RB * F.NGW) {
        u32x4 ka[RB], kb[RB]; bool ok[RB]; bf16_t* pp[RB];
#pragma unroll
        for (int k = 0; k < RB; ++k) { int r = r0 + k * F.NGW; ok[k] = r < NR; if (!ok[k]) r = r0;
            pp[k] = KN + (size_t)r * 1024 + hd * 64 + q4 * 16; ka[k] = *(const u32x4*)pp[k]; kb[k] = *(const u32x4*)(pp[k] + 8); }
#pragma unroll
        for (int k = 0; k < RB; ++k) {
            float x[16];
#pragma unroll
            for (int i = 0; i < 4; ++i) { x[2 * i] = bf_lo(ka[k][i]); x[2 * i + 1] = bf_hi(ka[k][i]); x[8 + 2 * i] = bf_lo(kb[k][i]); x[8 + 2 * i + 1] = bf_hi(kb[k][i]); }
            float sn = 0.f;
#pragma unroll
            for (int i = 0; i < 16; ++i) sn += x[i] * x[i];
            sn += __shfl_xor(sn, 1); sn += __shfl_xor(sn, 2);
            const float rn = rsqrtf(sn * (1.f / 64.f) + EPS);
            u32x4 u1, u2;
#pragma unroll
            for (int i = 0; i < 4; ++i) { u1[i] = cvtpk(x[2 * i] * rn * gkn[2 * i], x[2 * i + 1] * rn * gkn[2 * i + 1]); u2[i] = cvtpk(x[8 + 2 * i] * rn * gkn[8 + 2 * i], x[8 + 2 * i + 1] * rn * gkn[8 + 2 * i + 1]); }
            if (ok[k]) { *(u32x4*)pp[k] = u1; *(u32x4*)(pp[k] + 8) = u2; }
        }
    }
}

__global__ void __launch_bounds__(NWAVES * 64, 2) mega_fwd(Args args_) {
    extern __shared__ __attribute__((aligned(16))) unsigned char lds_raw[];
    KArgs kargs = (KArgs)__builtin_amdgcn_kernarg_segment_ptr();
#define a launder(kargs)
    Frame F;
    F.lds = (LAS unsigned char*)lds_raw;
    F.tid = threadIdx.x; F.lane = F.tid & 63; F.wave = __builtin_amdgcn_readfirstlane(F.tid >> 6);
    F.G = gridDim.x; { const int bx = blockIdx.x; F.vcu = (F.G % 8 == 0) ? (bx % 8) * (F.G / 8) + bx / 8 : bx; }
    F.gw = F.vcu * NWAVES + F.wave; F.NGW = F.G * NWAVES;
    unsigned char GAS* wsg = launder(kargs)->ws;
#define ws ((unsigned char*)wsg)
    volatile LAS unsigned* MISC = (volatile LAS unsigned*)(F.lds + MISC_OFF);
    for (int u = F.tid; u < (LDS_BYTES - LDSCTL_OFF) / 4; u += NWAVES * 64) ((LAS unsigned*)(F.lds + LDSCTL_OFF))[u] = 0u;
    __syncthreads();
    XcdBarrier bar = xcd_barrier_post((unsigned*)(ws + WS_CTL) + CW_BAR, MISC + 8);
#define GRID_BAR() do { asm volatile("" : "+s"(wsg)); bar.bar = (unsigned*)(ws + WS_CTL) + CW_BAR; bar.x = xb_xcc_id(); xcd_barrier(bar); asm volatile("" : "+s"(wsg)); } while (0)
#define H ((bf16_t*)(ws + WS_H))
#define xl OUTP(launder(kargs))
#define xc ((float*)(ws + WS_XCTX))
#define MOD ((const float*)(ws + WS_MOD))
    const int bx = (int)blockIdx.x;

    p0_phase(F, a);
    GRID_BAR();

    for (int L = 0; L < 4; ++L) {
        const int j = L >> 1;
        asm volatile("" : "+s"(wsg));
        norm1_phase(F, a, L);
        convert_experts(F, a, L);
        build_router_mod(F, a, L);
        GRID_BAR();
        if (!(L & 1)) {
            bf16_t* QK = (bf16_t*)(ws + WS_QK); bf16_t* VTE = (bf16_t*)(ws + WS_VTE); bf16_t* OB = (bf16_t*)(ws + WS_OB);
            { pg8::Gemm g{H, (const bf16_t*)(ws + WS_WQK) + (size_t)j * QKW * 1024, 1024, 1024, 1024, nullptr}; pg8::StaticOrder S; S.init(NR, QKW, F.G, bx);
              pg8::EpiBf16 E{QK, (size_t)QKW, 0x7fffffff}; pg8::gemm_phase<pg8::EpiBf16, pg8::StaticOrder>(F.lds, g, S, E); }
            { pg8::Gemm g{(const bf16_t*)(ws + WS_WVE) + (size_t)j * VEW * 1024, H, 1024, 1024, 1024, nullptr}; pg8::StaticOrder S; S.init(VEW, NR, F.G, (bx + F.G / 2) % F.G);
              pg8::EpiBf16 E{VTE, (size_t)NR, 0x7fffffff}; pg8::gemm_phase<pg8::EpiBf16, pg8::StaticOrder>(F.lds, g, S, E); }
            GRID_BAR();
            even_qk_phase(F, a, j);
            GRID_BAR();
            for (int i = 0;; ++i) { const int u = i * F.G + F.vcu; if (u >= 2048) break; const int sid = u >> 5, qb = u & 31, b = sid >> 3, hc = sid & 7, h = hc >> 1, c = hc & 1;
                att::attn_unit<64, 128>(QK + h * 128 + c * 64, QKW, QK + 512 + h * 128 + c * 64, QKW, nullptr, VTE + (size_t)(h * 128) * NR, OB + hc * 128, 1024, b * TPS + qb * 256, b * TPS, 132, F.lds, IN(a, I_AQK) + j * 128, (const f32x2*)(ws + WS_ROPE64), qb * 256); }
            for (int i = 0;; ++i) { const int u = i * F.G + F.vcu; if (u >= 2048) break; const int sid = u >> 5, qb = u & 31, b = sid >> 3, kvh = (sid >> 2) & 1, g = sid & 3;
                att::attn_unit<64, 64>(QK + 1024 + kvh * 256 + g * 64, QKW, QK + 1536 + kvh * 64, QKW, nullptr, VTE + (size_t)(512 + kvh * 64) * NR, H + 512 + kvh * 256 + g * 64, 1024, b * TPS + qb * 256, b * TPS, 132, F.lds, IN(a, I_BQK) + j * 128, (const f32x2*)(ws + WS_ROPE64), qb * 256); }
            if (L < 3) {
                for (int u = F.vcu; u < 64; u += F.G) { const int b = u >> 3, hc = u & 7, h = hc >> 1, c = hc & 1;
                    att::attn_unit<64, 128>(QK + h * 128 + c * 64, QKW, QK + 512 + h * 128 + c * 64, QKW, nullptr, VTE + (size_t)(h * 128) * NR, OB + hc * 128, 1024, b * TPS + SEQ, b * TPS + SEQ, 4, F.lds, IN(a, I_AQK) + j * 128, (const f32x2*)(ws + WS_ROPE64), -100000); }
                for (int u = F.vcu - 64; u < 64; u += F.G) { if (u < 0) continue; const int b = u >> 3, kvh = (u >> 2) & 1, g = u & 3;
                    att::attn_unit<64, 64>(QK + 1024 + kvh * 256 + g * 64, QKW, QK + 1536 + kvh * 64, QKW, nullptr, VTE + (size_t)(512 + kvh * 64) * NR, H + 512 + kvh * 256 + g * 64, 1024, b * TPS + SEQ, b * TPS + SEQ, 4, F.lds, IN(a, I_BQK) + j * 128, (const f32x2*)(ws + WS_ROPE64), -100000); }
            }
            GRID_BAR();
            even_merge_phase(F, a, j, L);
            GRID_BAR();
        } else {
            float* CRAW = (float*)(ws + WS_CRAW); bf16_t* CN = (bf16_t*)(ws + WS_CN); bf16_t* KR = (bf16_t*)(ws + WS_KR);
            bf16_t* Q = (bf16_t*)(ws + WS_Q); bf16_t* KN = (bf16_t*)(ws + WS_KN); bf16_t* VTO = (bf16_t*)(ws + WS_VTO);
            { pg8::Gemm g{H, (const bf16_t*)(ws + WS_WINO) + (size_t)j * 512 * 1024, 1024, 1024, 1024, nullptr}; pg8::StaticOrder S; S.init(NR, 512, F.G, bx);
              pg8::EpiF32 E{CRAW, (size_t)512}; pg8::gemm_phase<pg8::EpiF32, pg8::StaticOrder>(F.lds, g, S, E); }
            GRID_BAR();
            odd_c_phase(F, a, j);
            GRID_BAR();
            { pg8::Gemm g{CN, (const bf16_t*)(ws + WS_WQUP) + (size_t)j * 1536 * 256, CNW, 256, 256, nullptr}; pg8::StaticOrder S; if (L < 3) S.init(NR, QW, F.G, bx); else S.init(NB * SEQ, QW, F.G, bx, 1);
              pg8::EpiBf16 E{Q, (size_t)QW, 0x7fffffff}; pg8::gemm_phase<pg8::EpiBf16, pg8::StaticOrder>(F.lds, g, S, E); }
            int k128 = 128; asm volatile("" : "+s"(k128));
            { pg8::Gemm g{CN + 256, (const bf16_t*)(ws + WS_WKN) + (size_t)j * 1024 * 256, CNW, 256, k128, nullptr};     pg8::StaticOrder S; S.init(NR, 1024, F.G, (bx + F.G / 4) % F.G);
              pg8::EpiBf16 E{KN, (size_t)1024, 0x7fffffff}; pg8::gemm_phase<pg8::EpiBf16, pg8::StaticOrder>(F.lds, g, S, E); }
            { pg8::Gemm g{(const bf16_t*)(ws + WS_WVO) + (size_t)j * 1024 * 256, CN + 256, 256, CNW, k128, nullptr}; pg8::StaticOrder S; S.init(1024, NR, F.G, (bx + F.G / 2) % F.G);
              pg8::EpiBf16 E{VTO, (size_t)NR, 0x7fffffff}; pg8::gemm_phase<pg8::EpiBf16, pg8::StaticOrder>(F.lds, g, S, E); }
            GRID_BAR();
            odd_qk_phase(F, a, j);
            GRID_BAR();
            for (int i = 0;; ++i) { const int u = i * F.G + F.vcu; if (u >= 4096) break; const int sid = u >> 5, qb = u & 31, b = sid >> 4, h = sid & 15;
                att::attn_unit<96, 64>(Q + h * 96, QW, KN + h * 64, 1024, KR, VTO + (size_t)(h * 64) * NR, H + h * 64, 1024, b * TPS + qb * 256, b * TPS, 132, F.lds, IN(a, I_QKNORM) + j * 192, (const f32x2*)(ws + WS_ROPE32), qb * 256); }
            if (L < 3) {
                for (int u = F.vcu; u < 128; u += F.G) { const int b = u >> 4, h = u & 15;
                    att::attn_unit<96, 64>(Q + h * 96, QW, KN + h * 64, 1024, KR, VTO + (size_t)(h * 64) * NR, H + h * 64, 1024, b * TPS + SEQ, b * TPS + SEQ, 4, F.lds, IN(a, I_QKNORM) + j * 192, (const f32x2*)(ws + WS_ROPE32), -100000); }
            }
            GRID_BAR();
        }
        { const bf16_t* Wo = (L & 1) ? (const bf16_t*)(ws + WS_WOO) + (size_t)j * 1024 * 1024 : (const bf16_t*)(ws + WS_WOE) + (size_t)j * 1024 * 1024;
          pg8::Gemm g{H, Wo, 1024, 1024, 1024, nullptr}; pg8::StaticOrder S; if (L < 3) S.init(NR, 1024, F.G, bx); else S.init(NB * SEQ, 1024, F.G, bx, 1);
          pg8::EpiResid E{xl, xc, MOD + (size_t)L * 9 * 6 * 1024, 2}; pg8::gemm_phase<pg8::EpiResid, pg8::StaticOrder>(F.lds, g, S, E); }
        GRID_BAR();
        norm2_router_phase(F, a, L);
        GRID_BAR();
        topk_phase(F, a, L < 3 ? 256 : 128);
        GRID_BAR();
        { pg8::Gemm g{H, (const bf16_t*)(ws + WS_WGU), 1024, 1024, 1024, (const int*)(ws + WS_TOK)}; pg8::MoeOrder<8> S{F.G, F.vcu, L < 3 ? 33 : 32};
          pg8::EpiSwiGLU E{(bf16_t*)(ws + WS_GACT)}; pg8::gemm_phase<pg8::EpiSwiGLU, pg8::MoeOrder<8>, true>(F.lds, g, S, E); }
        GRID_BAR();
        { pg8::Gemm g{(const bf16_t*)(ws + WS_GACT), (const bf16_t*)(ws + WS_WD), 1024, 1024, 1024, nullptr}; pg8::MoeOrder<4> S{F.G, F.vcu, L < 3 ? 33 : 32};
          pg8::EpiBf16 E{(bf16_t*)(ws + WS_Y), (size_t)1024, 3}; pg8::gemm_phase<pg8::EpiBf16, pg8::MoeOrder<4>>(F.lds, g, S, E); }
        GRID_BAR();
    }
    norm1_phase(F, a, 4);
#undef a
#undef ws
#undef H
#undef xl
#undef xc
#undef MOD
}

extern "C" void kernel_launch(void* const* d_in, const int* in_sizes, int n_in, void* d_out, int out_size, void* d_ws, size_t ws_size, hipStream_t stream) {
    static int grid = 0;
    if (grid == 0) {
        if (n_in != 25 || in_sizes[0] != NB * SEQ * DM || out_size != NB * SEQ * DM || ws_size < WS_NEED) {
            fprintf(stderr, "kernel_launch: unexpected shapes (n_in %d, in0 %d, out %d, ws %zu < %zu); nothing launched\n", n_in, n_in > 0 ? in_sizes[0] : -1, out_size, ws_size, (size_t)WS_NEED); grid = -1; return; }
        int dev = 0, cus = 0;
        if (hipGetDevice(&dev) != hipSuccess || hipDeviceGetAttribute(&cus, hipDeviceAttributeMultiprocessorCount, dev) != hipSuccess) { grid = -1; return; }
        if (hipFuncSetAttribute((const void*)mega_fwd, hipFuncAttributeMaxDynamicSharedMemorySize, LDS_BYTES) != hipSuccess) { fprintf(stderr, "kernel_launch: hipFuncSetAttribute failed\n"); grid = -1; return; }
        (void)hipGetLastError();
        grid = cus;
    }
    if (grid < 0) return;
    if (hipMemsetAsync((char*)d_ws + WS_CTL, 0, CTL_BYTES, stream) != hipSuccess) return;
    Args a{};
    for (int i = 0; i < 25; ++i) a.in[i] = (const float GAS*)d_in[i];
    a.out = (float GAS*)d_out; a.ws = (unsigned char GAS*)d_ws;
    hipLaunchKernelGGL(mega_fwd, dim3(grid), dim3(NWAVES * 64), LDS_BYTES, stream, a);
}
```
